# Optimizing an MI355X kernel written in HIP

```python
import math
import jax, jax.numpy as jnp
from jax import lax
import numpy as np

D_MODEL = 1024
BATCH = 4
SEQ = 8192
DEPTH = 1

ATT_HEADS = 4
ATT_HEAD_DIM = 64
ATT_Q_WIDTH = ATT_HEADS * 2 * ATT_HEAD_DIM
ATT_V_DIM = 2 * ATT_HEAD_DIM
ATT_V_WIDTH = ATT_HEADS * ATT_V_DIM
ROPE_THETA = 10000.0
Q_BLOCK = 128
SUBLN_EPS = 1e-5
CONV_WIDTH = D_MODEL // 2
CONV_K = 3
N_BRANCHES = 2
IN_SIZES = (ATT_Q_WIDTH, ATT_Q_WIDTH, ATT_V_WIDTH, CONV_WIDTH, CONV_WIDTH, CONV_WIDTH, N_BRANCHES * D_MODEL)
IN_COLS = sum(IN_SIZES)
N_GROUPS = 4
EXPERTS_PER_GROUP = 8
N_EXPERTS = N_GROUPS * EXPERTS_PER_GROUP
TOP_K = 2
EXPERT_FF = D_MODEL // 2
MOE_BLOCK = 128
LN_EPS = 1e-5
DEEPNORM_ALPHA = (2.0 * DEPTH) ** 0.25
DEEPNORM_BETA = (8.0 * DEPTH) ** -0.25

kernel_name = "hybrid_diffattn_shortconv_hmoe_deepnorm"


def layer_norm(x, g, b):
    xf = x.astype(jnp.float32)
    mu = jnp.mean(xf, -1, keepdims=True)
    var = jnp.mean(jnp.square(xf - mu), -1, keepdims=True)
    return ((xf - mu) * lax.rsqrt(var + LN_EPS) * g.astype(jnp.float32) + b.astype(jnp.float32)).astype(x.dtype)


def rope_tables(positions):
    inv_freq = ROPE_THETA ** (-jnp.arange(0, ATT_HEAD_DIM, 2, dtype=jnp.float32) / ATT_HEAD_DIM)
    ang = positions.astype(jnp.float32)[..., None] * inv_freq
    ang = jnp.concatenate([ang, ang], -1)
    return jnp.cos(ang), jnp.sin(ang)


def apply_rope(t, cos, sin):
    c = cos[:, :, None, None, :]
    s = sin[:, :, None, None, :]
    t1, t2 = jnp.split(t, 2, axis=-1)
    rot = jnp.concatenate([-t2, t1], -1)
    return (t.astype(jnp.float32) * c + rot.astype(jnp.float32) * s).astype(t.dtype)


def diff_attention(q, k, v, lam):
    B, S = q.shape[0], q.shape[1]
    nqb = S // Q_BLOCK
    scale = ATT_HEAD_DIM ** -0.5
    kt = k.transpose(0, 2, 3, 1, 4)
    vt = v.transpose(0, 2, 1, 3)
    qb = q.reshape(B, nqb, Q_BLOCK, ATT_HEADS, 2, ATT_HEAD_DIM).transpose(1, 0, 3, 4, 2, 5)
    kpos = jnp.arange(S)
    neg = jnp.finfo(jnp.float32).min

    def block(args):
        qi, blk = args
        s = jnp.einsum('bhmqd,bhmkd->bhmqk', qi, kt, preferred_element_type=jnp.float32) * scale
        qpos = blk * Q_BLOCK + jnp.arange(Q_BLOCK)
        mask = kpos[None, :] <= qpos[:, None]
        p = jax.nn.softmax(jnp.where(mask, s, neg), axis=-1)
        a = p[:, :, 0] - lam * p[:, :, 1]
        return jnp.einsum('bhqk,bhkv->bhqv', a.astype(vt.dtype), vt)

    o = lax.map(block, (qb, jnp.arange(nqb)))
    return o.transpose(1, 0, 3, 2, 4).reshape(B, S, ATT_HEADS, ATT_V_DIM)


def short_conv(u, w):
    S = u.shape[1]
    up = jnp.pad(u, ((0, 0), (CONV_K - 1, 0), (0, 0)))
    y = w[0] * up[:, 0:S]
    for j in range(1, CONV_K):
        y = y + w[j] * up[:, j:j + S]
    return y


def hier_moe(x, w_rg, b_rg, w_re, b_re, w_gate, w_up, w_down):
    B, S, D = x.shape
    T = B * S
    xf = x.reshape(T, D)
    g_logits = (xf @ w_rg).astype(jnp.float32) + b_rg.astype(jnp.float32)
    g_prob = jax.nn.softmax(g_logits, -1)
    g_sel = jnp.argmax(g_logits, -1)
    g_w = jnp.take_along_axis(g_prob, g_sel[:, None], -1)[:, 0]
    e_logits = ((xf @ w_re).astype(jnp.float32) + b_re.astype(jnp.float32)).reshape(T, N_GROUPS, EXPERTS_PER_GROUP)
    e_logits = jnp.take_along_axis(e_logits, g_sel[:, None, None], 1)[:, 0]
    top_v, top_i = lax.top_k(e_logits, TOP_K)
    top_p = jax.nn.softmax(top_v, -1) * g_w[:, None]
    expert_id = g_sel[:, None].astype(jnp.int32) * EXPERTS_PER_GROUP + top_i.astype(jnp.int32)

    A = T * TOP_K
    e_flat = expert_id.reshape(A)
    tok_flat = jnp.repeat(jnp.arange(T, dtype=jnp.int32), TOP_K)
    w_flat = top_p.reshape(A)
    order = jnp.argsort(e_flat)
    e_sorted = e_flat[order]
    tok_sorted = tok_flat[order]
    w_sorted = w_flat[order]
    counts = jnp.bincount(e_flat, length=N_EXPERTS).astype(jnp.int32)
    padded = (counts + MOE_BLOCK - 1) // MOE_BLOCK * MOE_BLOCK
    start = jnp.cumsum(counts) - counts
    pend = jnp.cumsum(padded)
    pstart = pend - padded
    dest = pstart[e_sorted] + jnp.arange(A, dtype=jnp.int32) - start[e_sorted]
    P = A + N_EXPERTS * MOE_BLOCK
    NB = P // MOE_BLOCK
    slot_tok = jnp.full((P,), T, jnp.int32).at[dest].set(tok_sorted)
    slot_w = jnp.zeros((P,), jnp.float32).at[dest].set(w_sorted)
    block_expert = jnp.minimum(
        jnp.searchsorted(pend, jnp.arange(NB, dtype=jnp.int32) * MOE_BLOCK, side='right'), N_EXPERTS - 1)
    x_pad = jnp.concatenate([xf, jnp.zeros((1, D), xf.dtype)], 0)
    xs = x_pad[slot_tok].reshape(NB, MOE_BLOCK, D)

    def run(args):
        xb, e = args
        h = jax.nn.silu(xb @ w_gate[e]) * (xb @ w_up[e])
        return h @ w_down[e]

    ys = lax.map(run, (xs, block_expert)).reshape(P, D)
    out = jnp.zeros((T + 1, D), jnp.float32).at[slot_tok].add(ys.astype(jnp.float32) * slot_w[:, None])
    return out[:T].reshape(B, S, D).astype(x.dtype)


def setup_inputs(seed: int = 0) -> dict:
    key = jax.random.key(seed)
    ks = jax.random.split(key, 24)
    f32 = jnp.float32
    nrm = lambda k, shape, s: jax.random.normal(k, shape, f32) * s
    x = jax.random.normal(ks[0], (BATCH, SEQ, D_MODEL), f32)
    positions = jnp.broadcast_to(jnp.arange(SEQ, dtype=jnp.int32), (BATCH, SEQ))
    col_scale = jnp.concatenate([
        jnp.ones((2 * ATT_Q_WIDTH,), f32),
        jnp.full((ATT_V_WIDTH,), DEEPNORM_BETA, f32),
        jnp.ones((3 * CONV_WIDTH + N_BRANCHES * D_MODEL,), f32)])
    w_in = nrm(ks[1], (DEPTH, D_MODEL, IN_COLS), D_MODEL ** -0.5) * col_scale
    b_gate = nrm(ks[2], (DEPTH, N_BRANCHES * D_MODEL), 0.02)
    lambda_q1 = nrm(ks[3], (DEPTH, ATT_HEAD_DIM), 0.1)
    lambda_k1 = nrm(ks[4], (DEPTH, ATT_HEAD_DIM), 0.1)
    lambda_q2 = nrm(ks[5], (DEPTH, ATT_HEAD_DIM), 0.1)
    lambda_k2 = nrm(ks[6], (DEPTH, ATT_HEAD_DIM), 0.1)
    subln_g = 1.0 + nrm(ks[7], (DEPTH, ATT_V_DIM), 0.02)
    w_o_att = nrm(ks[8], (DEPTH, ATT_V_WIDTH, D_MODEL), ATT_V_WIDTH ** -0.5 * DEEPNORM_BETA)
    conv_w = nrm(ks[9], (DEPTH, CONV_K, CONV_WIDTH), CONV_K ** -0.5)
    w_o_conv = nrm(ks[10], (DEPTH, CONV_WIDTH, D_MODEL), CONV_WIDTH ** -0.5 * DEEPNORM_BETA)
    w_mix_out = nrm(ks[11], (DEPTH, D_MODEL, D_MODEL), D_MODEL ** -0.5 * DEEPNORM_BETA)
    ln1_g = 1.0 + nrm(ks[12], (DEPTH, D_MODEL), 0.02)
    ln1_b = nrm(ks[13], (DEPTH, D_MODEL), 0.02)
    w_router_group = nrm(ks[14], (DEPTH, D_MODEL, N_GROUPS), D_MODEL ** -0.5)
    b_router_group = nrm(ks[15], (DEPTH, N_GROUPS), 0.01)
    w_router_expert = nrm(ks[16], (DEPTH, D_MODEL, N_EXPERTS), D_MODEL ** -0.5)
    b_router_expert = nrm(ks[17], (DEPTH, N_EXPERTS), 0.01)
    w_exp_gate = nrm(ks[18], (DEPTH, N_EXPERTS, D_MODEL, EXPERT_FF), D_MODEL ** -0.5)
    w_exp_up = nrm(ks[19], (DEPTH, N_EXPERTS, D_MODEL, EXPERT_FF), D_MODEL ** -0.5 * DEEPNORM_BETA)
    w_exp_down = nrm(ks[20], (DEPTH, N_EXPERTS, EXPERT_FF, D_MODEL), EXPERT_FF ** -0.5 * DEEPNORM_BETA)
    ln2_g = 1.0 + nrm(ks[21], (DEPTH, D_MODEL), 0.02)
    ln2_b = nrm(ks[22], (DEPTH, D_MODEL), 0.02)
    return {"x": x, "positions": positions, "w_in": w_in, "b_gate": b_gate,
            "lambda_q1": lambda_q1, "lambda_k1": lambda_k1, "lambda_q2": lambda_q2, "lambda_k2": lambda_k2,
            "subln_g": subln_g, "w_o_att": w_o_att, "conv_w": conv_w, "w_o_conv": w_o_conv,
            "w_mix_out": w_mix_out, "ln1_g": ln1_g, "ln1_b": ln1_b,
            "w_router_group": w_router_group, "b_router_group": b_router_group,
            "w_router_expert": w_router_expert, "b_router_expert": b_router_expert,
            "w_exp_gate": w_exp_gate, "w_exp_up": w_exp_up, "w_exp_down": w_exp_down,
            "ln2_g": ln2_g, "ln2_b": ln2_b}


def reference(x, positions, w_in, b_gate, lambda_q1, lambda_k1, lambda_q2, lambda_k2, subln_g, w_o_att,
              conv_w, w_o_conv, w_mix_out, ln1_g, ln1_b, w_router_group, b_router_group, w_router_expert,
              b_router_expert, w_exp_gate, w_exp_up, w_exp_down, ln2_g, ln2_b):
    B, S, D = x.shape
    cos, sin = rope_tables(positions)
    split_pts = [int(v) for v in np.cumsum(IN_SIZES)[:-1]]
    h = x
    for l in range(DEPTH):
        lambda_init = 0.8 - 0.6 * math.exp(-0.3 * l)
        proj = h @ w_in[l]
        q, k, v, cb, cc, cx, gates = jnp.split(proj, split_pts, axis=-1)
        q = apply_rope(q.reshape(B, S, ATT_HEADS, 2, ATT_HEAD_DIM), cos, sin)
        k = apply_rope(k.reshape(B, S, ATT_HEADS, 2, ATT_HEAD_DIM), cos, sin)
        v = v.reshape(B, S, ATT_HEADS, ATT_V_DIM)
        lam = (jnp.exp(jnp.sum(lambda_q1[l].astype(jnp.float32) * lambda_k1[l].astype(jnp.float32)))
               - jnp.exp(jnp.sum(lambda_q2[l].astype(jnp.float32) * lambda_k2[l].astype(jnp.float32)))
               + lambda_init)
        o = diff_attention(q, k, v, lam).astype(jnp.float32)
        o = o * lax.rsqrt(jnp.mean(jnp.square(o), -1, keepdims=True) + SUBLN_EPS)
        o = (o * subln_g[l].astype(jnp.float32) * (1.0 - lambda_init)).astype(h.dtype)
        y_att = o.reshape(B, S, ATT_V_WIDTH) @ w_o_att[l]
        y_conv = (cb * short_conv(cc * cx, conv_w[l])) @ w_o_conv[l]
        g = jax.nn.sigmoid(gates.astype(jnp.float32) + b_gate[l].astype(jnp.float32)).reshape(B, S, N_BRANCHES, D)
        merged = (g[:, :, 0] * y_att.astype(jnp.float32) + g[:, :, 1] * y_conv.astype(jnp.float32)).astype(h.dtype)
        h = layer_norm(DEEPNORM_ALPHA * h + merged @ w_mix_out[l], ln1_g[l], ln1_b[l])
        ffn = hier_moe(h, w_router_group[l], b_router_group[l], w_router_expert[l], b_router_expert[l],
                       w_exp_gate[l], w_exp_up[l], w_exp_down[l])
        h = layer_norm(DEEPNORM_ALPHA * h + ffn, ln2_g[l], ln2_b[l])
    return h
```

```cpp
#include <hip/hip_runtime.h>
#include <cstdio>
#include <cstdint>
#include <cmath>

#define GAS __attribute__((address_space(1)))
#define LAS __attribute__((address_space(3)))
typedef unsigned short bf16;
typedef unsigned v4u __attribute__((ext_vector_type(4)));
typedef unsigned v2u __attribute__((ext_vector_type(2)));
typedef float f32x4 __attribute__((ext_vector_type(4)));
typedef float f32x16 __attribute__((ext_vector_type(16)));
typedef short bf16x8 __attribute__((ext_vector_type(8)));
typedef GAS unsigned gu32;
#define RLX_AGENT __ATOMIC_RELAXED, __HIP_MEMORY_SCOPE_AGENT
#define LDS_WAIT() asm volatile("s_waitcnt lgkmcnt(0)" ::: "memory")
#define VM_WAIT() asm volatile("s_waitcnt vmcnt(0)" ::: "memory")


constexpr int NWAVES = 8;
constexpr int BATCH = 4, SEQ = 8192, T = BATCH * SEQ, D = 1024, NPROJ = 5120;
constexpr int NE = 32, FF = 512, LISTCAP = 32768;
constexpr float LN_EPS = 1e-5f, SUBLN_EPS = 1e-5f;
constexpr float ALPHA = 1.189207115002721f;
constexpr float LAMBDA_INIT = 0.2f;
constexpr float C2 = 0.125f * 1.4426950408889634f;

constexpr size_t MiB = 1u << 20;
constexpr size_t WS_CTL = 0, CTL_ZERO_BYTES = 1 * MiB;
constexpr size_t WS_ROPE = 1 * MiB;
constexpr size_t WS_LIST = 448 * MiB;
constexpr size_t WS_WGT = 13 * MiB;
constexpr size_t WS_WRT = 14 * MiB;
constexpr size_t WS_WIN = 16 * MiB;
constexpr size_t WS_WOA = 26 * MiB, WS_WOC = 27 * MiB, WS_WMIX = 28 * MiB;
constexpr size_t WS_WGU = 32 * MiB;
constexpr size_t WS_WD = 96 * MiB;
constexpr size_t WS_XB = 128 * MiB;
constexpr size_t WS_OR = 128 * MiB;
constexpr size_t WS_YS = 128 * MiB;
constexpr size_t WS_Q = 192 * MiB, WS_K = 224 * MiB, WS_V = 256 * MiB;
constexpr size_t WS_MG = 192 * MiB;
constexpr size_t WS_H1B = 256 * MiB;
constexpr size_t WS_CB = 288 * MiB, WS_U = 320 * MiB;
constexpr size_t WS_OB = 288 * MiB;
constexpr size_t WS_F = 352 * MiB;
constexpr size_t WS_HM = 320 * MiB;
constexpr size_t WS_G = 384 * MiB;
constexpr size_t WS_END = 512 * MiB;
constexpr int CW_CNT = 1024;
constexpr int CW_RDY = 16384;
constexpr int CW_BAR = 4096;

constexpr int RING_OFF = 0, RING_BYTES = 135168;
constexpr int LDSCTL_OFF = RING_BYTES, MISC_OFF = LDSCTL_OFF + 320;
constexpr int LDS_BYTES = 151552;

__device__ __forceinline__ unsigned f2bf(float f) { unsigned u = __builtin_bit_cast(unsigned, f); return (u + 0x7fffu + ((u >> 16) & 1u)) >> 16; }
__device__ __forceinline__ unsigned pk2(float lo, float hi) { return f2bf(lo) | (f2bf(hi) << 16); }
__device__ __forceinline__ float bflo(unsigned u) { return __uint_as_float(u << 16); }
__device__ __forceinline__ float bfhi(unsigned u) { return __uint_as_float(u & 0xffff0000u); }
__device__ __forceinline__ float bf2f(bf16 h) { return __uint_as_float((unsigned)h << 16); }

__device__ __forceinline__ int lane_id() { return (int)__builtin_amdgcn_mbcnt_hi(~0u, __builtin_amdgcn_mbcnt_lo(~0u, 0u)); }
#define XB_TMO      128
#define XB_XCNT(j)  (256  + 64 * (j))
#define XB_XSUB(j)  (1280 + 64 * (j))
#define XB_XGEN(j)  (2304 + 64 * (j))
#define XB_TOP      3328
#define XB_TOPGEN   3392
#define XCD_BAR_WORDS 3456
#define XB_SPIN_CAP (1u << 26)

__device__ __forceinline__ unsigned xb_ld(unsigned* p)              { return __hip_atomic_load(p, __ATOMIC_RELAXED, __HIP_MEMORY_SCOPE_AGENT); }
__device__ __forceinline__ unsigned xb_add(unsigned* p, unsigned v) { return __hip_atomic_fetch_add(p, v, __ATOMIC_RELAXED, __HIP_MEMORY_SCOPE_AGENT); }
__device__ __forceinline__ unsigned xb_xcc_id() { return (unsigned)__builtin_amdgcn_s_getreg((3 << 11) | 20) & 0xFu; }
#define XB_SPIN(cond, bar) do { unsigned _sp = 0; while (cond) { __builtin_amdgcn_s_sleep(1); \
    if ((++_sp & 255u) == 0u) { if (xb_ld(&(bar)[XB_TMO])) break; if (_sp > XB_SPIN_CAP) { atomicAdd(&(bar)[XB_TMO], 1u); break; } } } } while (0)

struct XcdBarrier { unsigned* bar; unsigned x; volatile LAS unsigned* st; int wave; };

__device__ __forceinline__ XcdBarrier xcd_barrier_post(unsigned* bar, volatile LAS unsigned* st) {
    XcdBarrier b; b.bar = bar; b.x = xb_xcc_id(); b.st = st; b.wave = __builtin_amdgcn_readfirstlane((int)threadIdx.x >> 6);
    if (threadIdx.x == 0) (void)xb_add(&bar[XB_XCNT(b.x)], 1u);
    return b;
}
__device__ __forceinline__ void xcd_barrier_complete(unsigned* bar, unsigned x, unsigned& nloc, unsigned& nx) {
    const unsigned G = gridDim.x * gridDim.y * gridDim.z;
    unsigned sum, cnt, mine, sp = 0u;
    for (;;) {
        sum = 0u; cnt = 0u; mine = 0u;
#pragma unroll
        for (unsigned j = 0; j < 16; ++j) { const unsigned c = xb_ld(&bar[XB_XCNT(j)]); sum += c; cnt += (c > 0u) ? 1u : 0u; mine = (j == x) ? c : mine; }
        if (sum == G) break;
        __builtin_amdgcn_s_sleep(1);
        if ((++sp & 255u) == 0u) { if (xb_ld(&bar[XB_TMO])) break; if (sp > XB_SPIN_CAP) { atomicAdd(&bar[XB_TMO], 1u); break; } }
    }
    nloc = mine > 0u ? mine : 1u; nx = cnt > 0u ? cnt : 1u;
}
__device__ __forceinline__ void xcd_barrier(const XcdBarrier& b) {
    asm volatile("s_waitcnt vmcnt(0)" ::: "memory");
    __syncthreads();
    if (b.wave == 0 && lane_id() == 0) {
        unsigned* bar = b.bar;
        __builtin_amdgcn_s_waitcnt(0);
        unsigned nloc = b.st[0], nx = b.st[1];
        if (nloc == 0u) { xcd_barrier_complete(bar, b.x, nloc, nx); b.st[0] = nloc; b.st[1] = nx; }
        const unsigned old = xb_add(&bar[XB_XSUB(b.x)], 1u);
        const unsigned gen = old / nloc;
        if (old + 1u == (gen + 1u) * nloc) {
            __builtin_amdgcn_fence(__ATOMIC_RELEASE, "agent");
            asm volatile("s_waitcnt vmcnt(0)" ::: "memory");
            const unsigned og = xb_add(&bar[XB_TOP], 1u);
            const unsigned tg = og / nx;
            if (og + 1u == (tg + 1u) * nx) xb_add(&bar[XB_TOPGEN], 1u);
            else XB_SPIN(xb_ld(&bar[XB_TOPGEN]) == tg, bar);
            __builtin_amdgcn_fence(__ATOMIC_ACQUIRE, "agent");
            xb_add(&bar[XB_XGEN(b.x)], 1u);
            asm volatile("s_waitcnt vmcnt(0)" ::: "memory");
        } else {
            XB_SPIN(xb_ld(&bar[XB_XGEN(b.x)]) == gen, bar);
            __builtin_amdgcn_fence(__ATOMIC_ACQUIRE, "agent");
            asm volatile("s_waitcnt vmcnt(0)" ::: "memory");
        }
    }
    __syncthreads();
}

__host__ __device__ __forceinline__ int orig_of(int n) {
    const int tile = n >> 8, c = n & 255;
    if (tile < 4) { const int base = (tile >> 1) * 512 + (tile & 1) * 256, half = c >> 7, cc = c & 127, g = cc >> 5, i = cc & 31; return base + g * 64 + half * 32 + i; }
    if (tile >= 8 && tile < 12) { const int p = tile - 8, half = c >> 7; return 2048 + half * 512 + p * 128 + (c & 127); }
    return n;
}
__host__ __device__ __forceinline__ int n_of(int orig) {
    if (orig < 1024) { const int sec = orig >> 9, o = orig & 511, tl = o >> 8, o2 = o & 255, g = o2 >> 6, d = o2 & 63, half = d >> 5, i = d & 31; return (sec * 2 + tl) * 256 + half * 128 + g * 32 + i; }
    if (orig >= 2048 && orig < 3072) { const int o = orig - 2048, half = o >> 9, ch = o & 511, p = ch >> 7; return (8 + p) * 256 + half * 128 + (ch & 127); }
    return orig;
}

__device__ __forceinline__ float wave_sum(float v) {
#pragma unroll
    for (int o = 1; o < 64; o <<= 1) v += __shfl_xor(v, o);
    return v;
}
__device__ __forceinline__ void transpose_item(const float* W, int K, int N, bf16* WT, int k0, int n0, int dst_row0, LAS float* scr, int lane, int ldk = 0) {
    if (ldk == 0) ldk = K;
    float tv[32];
#pragma unroll
    for (int i = 0; i < 32; ++i) tv[i] = W[(size_t)(k0 + 2 * i + (lane >> 5)) * N + n0 + (lane & 31)];
#pragma unroll
    for (int i = 0; i < 32; ++i) scr[(2 * i + (lane >> 5)) * 33 + (lane & 31)] = tv[i];
    LDS_WAIT(); asm volatile("" ::: "memory");
    const int c = lane & 7;
#pragma unroll
    for (int j = 0; j < 4; ++j) { const int n = (lane >> 3) + 8 * j; const LAS float* s = scr + (8 * c) * 33 + n;
        v4u o; o.x = pk2(s[0 * 33], s[1 * 33]); o.y = pk2(s[2 * 33], s[3 * 33]); o.z = pk2(s[4 * 33], s[5 * 33]); o.w = pk2(s[6 * 33], s[7 * 33]);
        *(GAS v4u*)(WT + (size_t)(dst_row0 + n) * ldk + k0 + 8 * c) = o; }
    LDS_WAIT(); asm volatile("" ::: "memory");
}
__device__ __forceinline__ void transpose_load_nl(const float* W, int N, int k0, int n0, int lane, float (&tv)[32]) {
#pragma unroll
    for (int i = 0; i < 32; ++i) tv[i] = W[(size_t)(k0 + (lane >> 5) * 32 + i) * N + n0 + (lane & 31)];
}
__device__ __forceinline__ void transpose_store_nl(const float (&tv)[32], int K, bf16* WT, int k0, int dst_row0, int lane) {
#pragma unroll
    for (int j = 0; j < 4; ++j) { v4u o; o.x = pk2(tv[8 * j], tv[8 * j + 1]); o.y = pk2(tv[8 * j + 2], tv[8 * j + 3]); o.z = pk2(tv[8 * j + 4], tv[8 * j + 5]); o.w = pk2(tv[8 * j + 6], tv[8 * j + 7]);
        *(GAS v4u*)(WT + (size_t)(dst_row0 + (lane & 31)) * K + k0 + (lane >> 5) * 32 + 8 * j) = o; }
}
__device__ __forceinline__ int crow(int r, int hi) { return (r & 3) + 8 * (r >> 2) + 4 * hi; }

namespace pg8 {
#define PG8_LAS __attribute__((address_space(3)))
typedef unsigned short bf16_t;
typedef short bf16x8 __attribute__((ext_vector_type(8)));
typedef float f32x4 __attribute__((ext_vector_type(4)));
typedef unsigned u32x4 __attribute__((ext_vector_type(4)));
constexpr int BM = 256, BK = 64, HALF = 128, HTB = HALF * BK * 2  , STAGE_BYTES = 8 * HTB, NXCD = 8, WGM = 8;

__host__ __device__ __forceinline__ int lds_byte(int r, int c) { const int st = (r >> 4) * 2 + (c >> 5), rr = r & 15, cc = c & 31, ob = rr * 64 + cc * 2; return st * 1024 + (ob ^ (((ob >> 9) & 1) << 5)); }
__host__ __device__ __forceinline__ void stage_rc(int b, int& R, int& C) { const int st = b / 1024, sb = b % 1024, swz = sb ^ (((sb >> 9) & 1) << 5); R = (st >> 1) * 16 + swz / 64; C = (st & 1) * 32 + (swz % 64) / 2; }
__host__ __device__ __forceinline__ int perm32(int rho) { const int n = rho >> 4, i = rho & 15; return 8 * (i >> 2) + 4 * n + (i & 3); }

struct Unit { int pm, pn; };
struct Gemm { const bf16_t* A; const bf16_t* Bt; int M, N, K; };

struct StaticOrder {
    int nM, nN, nwg, G, c;
    __host__ __device__ void init(int M, int N, int G_, int c_) { nM = M / BM; nN = N / BM; nwg = nM * nN; G = G_; c = c_; }
    __host__ __device__ bool next(int i, Unit& u) const {
        const long L = (long)i * G + c; if (L >= nwg) return false;
        int wgid = (int)L; { const int q = nwg / NXCD, r = nwg % NXCD, xcd = wgid % NXCD, off = wgid / NXCD; wgid = (xcd < r ? xcd * (q + 1) : r * (q + 1) + (xcd - r) * q) + off; }
        const int nig = WGM * nN, gid = wgid / nig, fm = gid * WGM, gsz = (nM - fm) < WGM ? (nM - fm) : WGM;
        u.pm = fm + ((wgid % nig) % gsz); u.pn = (wgid % nig) / gsz; return true;
    }
    __device__ __forceinline__ void a_ready(const Unit&) const {}
    __device__ __forceinline__ void done(const Unit&) const {}
};

typedef float f32x2c __attribute__((ext_vector_type(2))); typedef __bf16 bf16x2c __attribute__((ext_vector_type(2)));
__device__ __forceinline__ unsigned cvt_pk_bf16(float lo, float hi) { const f32x2c v = {lo, hi}; const bf16x2c b = __builtin_convertvector(v, bf16x2c); return __builtin_bit_cast(unsigned, b); }
typedef float f32x2 __attribute__((ext_vector_type(2)));

typedef unsigned u32x2 __attribute__((ext_vector_type(2)));
__device__ __forceinline__ u32x4 pack8(const f32x4 a, const f32x4 b) { u32x4 w; w.x = cvt_pk_bf16(a[0], a[1]); w.y = cvt_pk_bf16(a[2], a[3]); w.z = cvt_pk_bf16(b[0], b[1]); w.w = cvt_pk_bf16(b[2], b[3]); return w; }
__device__ __forceinline__ float sigmoidf_fast(float z) { return __builtin_amdgcn_rcpf(1.0f + __expf(-z)); }
struct EpiProj {
    static constexpr bool PERM = true, AFTER_DRAIN = false;
    bf16_t *Q, *K, *V, *CB, *U, *G; const float* rope; const float* bgate; float c2;
    __device__ __forceinline__ void operator()(const f32x4 (&acc)[2][2][4][2], const Unit& u, int wr, int wc, int fr, int fq) const {
        const int row0 = u.pm * BM + wr * 64 + fr, tile = u.pn;
        if (tile < 4) {
            bf16_t* dst = (tile < 2 ? Q : K) + ((tile & 1) * 4 + wc) * 64 + 8 * fq; const float sc = tile < 2 ? c2 : 1.f;
#pragma unroll
            for (int ai = 0; ai < 2; ++ai) {
                f32x4 cst[4][4];
#pragma unroll
                for (int m = 0; m < 4; ++m) { const f32x4* cs = (const f32x4*)(rope + (size_t)(row0 + ai * HALF + m * 16) * 64 + 16 * fq);
#pragma unroll
                    for (int q = 0; q < 4; ++q) cst[m][q] = cs[q]; }
#pragma unroll
                for (int m = 0; m < 4; ++m) { const int t = row0 + ai * HALF + m * 16;
                    f32x4 lo[2], hi[2], ol[2], oh[2];
                    lo[0] = acc[ai][0][m][0]; lo[1] = acc[ai][0][m][1]; hi[0] = acc[ai][1][m][0]; hi[1] = acc[ai][1][m][1];
#pragma unroll
                    for (int n = 0; n < 2; ++n) { const f32x4 ca = cst[m][2 * n], cb = cst[m][2 * n + 1];
                        ol[n][0] = (lo[n][0] * ca.x - hi[n][0] * ca.y) * sc; oh[n][0] = (hi[n][0] * ca.x + lo[n][0] * ca.y) * sc;
                        ol[n][1] = (lo[n][1] * ca.z - hi[n][1] * ca.w) * sc; oh[n][1] = (hi[n][1] * ca.z + lo[n][1] * ca.w) * sc;
                        ol[n][2] = (lo[n][2] * cb.x - hi[n][2] * cb.y) * sc; oh[n][2] = (hi[n][2] * cb.x + lo[n][2] * cb.y) * sc;
                        ol[n][3] = (lo[n][3] * cb.z - hi[n][3] * cb.w) * sc; oh[n][3] = (hi[n][3] * cb.z + lo[n][3] * cb.w) * sc; }
                    bf16_t* rowp = dst + (size_t)t * 512;
                    *(u32x4*)rowp = pack8(ol[0], ol[1]); *(u32x4*)(rowp + 32) = pack8(oh[0], oh[1]); } }
        } else if (tile < 8) {
            bf16_t* dst = (tile < 6 ? V : CB) + (tile & 1) * 256 + wc * 32 + 8 * fq;
#pragma unroll
            for (int ai = 0; ai < 2; ++ai)
#pragma unroll
                for (int m = 0; m < 4; ++m) { bf16_t* rowp = dst + (size_t)(row0 + ai * HALF + m * 16) * 512;
#pragma unroll
                    for (int bj = 0; bj < 2; ++bj) *(u32x4*)(rowp + bj * HALF) = pack8(acc[ai][bj][m][0], acc[ai][bj][m][1]); }
        } else if (tile < 12) {
            bf16_t* dst = U + (tile - 8) * 128 + wc * 32 + 8 * fq;
#pragma unroll
            for (int ai = 0; ai < 2; ++ai)
#pragma unroll
                for (int m = 0; m < 4; ++m) *(u32x4*)(dst + (size_t)(row0 + ai * HALF + m * 16) * 512) = pack8(acc[ai][0][m][0] * acc[ai][1][m][0], acc[ai][0][m][1] * acc[ai][1][m][1]);
        } else {
            const int gc = (tile - 12) * 256 + wc * 32 + 8 * fq;
            f32x4 bv[2][2];
#pragma unroll
            for (int bj = 0; bj < 2; ++bj)
#pragma unroll
                for (int n = 0; n < 2; ++n) bv[bj][n] = *(const f32x4*)(bgate + gc + bj * HALF + 4 * n);
#pragma unroll
            for (int ai = 0; ai < 2; ++ai)
#pragma unroll
                for (int m = 0; m < 4; ++m) { bf16_t* rowp = G + (size_t)(row0 + ai * HALF + m * 16) * 2048 + gc;
#pragma unroll
                    for (int bj = 0; bj < 2; ++bj) { f32x4 v0 = acc[ai][bj][m][0] + bv[bj][0], v1 = acc[ai][bj][m][1] + bv[bj][1];
#pragma unroll
                        for (int e = 0; e < 4; ++e) { v0[e] = sigmoidf_fast(v0[e]); v1[e] = sigmoidf_fast(v1[e]); }
                        *(u32x4*)(rowp + bj * HALF) = pack8(v0, v1);
                    } }
        }
    }
};
template <class Epi, class Sched, bool ALIGN_EPI = false, bool SP2 = false>
__device__ __forceinline__ void gemm_phase(PG8_LAS unsigned char* lds, const Gemm g, const Sched& S, const Epi& E, const int wid_in) {
    int tid_ = wid_in * 64 + (int)__builtin_amdgcn_mbcnt_hi(~0u, __builtin_amdgcn_mbcnt_lo(~0u, 0u)); asm volatile("" : "+v"(tid_));
    const int tid = tid_, wid = __builtin_amdgcn_readfirstlane(tid >> 6), lane = tid & 63, wr = wid >> 2, wc = wid & 3, fr = lane & 15, fq = lane >> 4;
    const int K = g.K, nt = K / BK;
    unsigned voffA[2], voffB[2];
#pragma unroll
    for (int i = 0; i < 2; ++i) { int R, C; stage_rc(tid * 16 + i * 8192, R, C); const int Rb = Epi::PERM ? ((R & ~31) + perm32(R & 31)) : R;
        voffA[i] = (unsigned)(R * K + C) * 2u; voffB[i] = (unsigned)(Rb * K + C) * 2u; }
    const size_t kstep = (size_t)(BK * 2);
    const size_t hstep = (size_t)HALF * K * 2;
    const size_t tstep = 2 * hstep;
    const unsigned ldsw = (unsigned)wid * 1024u;
    const int aoff = lds_byte(wr * 64 + fr, fq * 8), boff = lds_byte(wc * 32 + fr, fq * 8);
#define PG8_SA(b, h) (((b) * 2 + (h)) * HTB)
#define PG8_SB(b, h) ((4 + (b) * 2 + (h)) * HTB)
#define PG8_STAGE(bufoff, gbase, voff) do { _Pragma("unroll") for (int _i = 0; _i < 2; ++_i) \
        __builtin_amdgcn_global_load_lds((const unsigned*)((const char*)(gbase) + (voff)[_i]), (PG8_LAS unsigned*)(lds + (bufoff) + ldsw + _i * 8192), 16, 0, 0); } while (0)
#define PG8_LDA(dst, b, h) do { _Pragma("unroll") for (int m = 0; m < 4; ++m) _Pragma("unroll") for (int k = 0; k < 2; ++k) dst[m][k] = *(const PG8_LAS bf16x8*)(lds + PG8_SA(b, h) + aoff + m * 2048 + k * 1024); } while (0)
#define PG8_LDB(dst, b, h) do { _Pragma("unroll") for (int n = 0; n < 2; ++n) _Pragma("unroll") for (int k = 0; k < 2; ++k) dst[n][k] = *(const PG8_LAS bf16x8*)(lds + PG8_SB(b, h) + boff + n * 2048 + k * 1024); } while (0)
#define PG8_MMA(ai, bj, At, Bt) do { __builtin_amdgcn_s_setprio(1); _Pragma("unroll") for (int m = 0; m < 4; ++m) _Pragma("unroll") for (int n = 0; n < 2; ++n) _Pragma("unroll") for (int k = 0; k < 2; ++k) \
        acc[ai][bj][m][n] = __builtin_amdgcn_mfma_f32_16x16x32_bf16(Bt[n][k], At[m][k], acc[ai][bj][m][n], 0, 0, 0); __builtin_amdgcn_s_setprio(0); } while (0)
#define PG8_WAIT_V(n) asm volatile("s_waitcnt vmcnt(" #n ")" ::: "memory")
#define PG8_WAIT_L(n) asm volatile("s_waitcnt lgkmcnt(" #n ")" ::: "memory")
#define PG8_BAR __builtin_amdgcn_s_barrier()
#define PG8_SCHED __builtin_amdgcn_sched_barrier(0)
    Unit cur, nxt; int ui = 0;
    if (!S.next(0, cur)) return;
    f32x4 acc[2][2][4][2];
#pragma unroll
    for (int a = 0; a < 2; ++a)
#pragma unroll
        for (int b = 0; b < 2; ++b)
#pragma unroll
            for (int m = 0; m < 4; ++m)
#pragma unroll
                for (int n = 0; n < 2; ++n) acc[a][b][m][n] = (f32x4){0.f, 0.f, 0.f, 0.f};
    bf16x8 At[4][2], B0[2][2], B1[2][2];
    const char* cA = (const char*)g.A + (size_t)cur.pm * tstep; const char* cB = (const char*)g.Bt + (size_t)cur.pn * tstep;
    S.a_ready(cur);
    if constexpr (SP2) {
        PG8_STAGE(PG8_SB(0, 0), cB, voffB); PG8_STAGE(PG8_SB(0, 1), cB + hstep, voffB); PG8_STAGE(PG8_SA(0, 0), cA, voffA); PG8_STAGE(PG8_SA(0, 1), cA + hstep, voffA);
        if (wr == 1) PG8_BAR;
        PG8_WAIT_V(2); PG8_BAR;
        PG8_STAGE(PG8_SB(1, 0), cB + kstep, voffB); PG8_STAGE(PG8_SA(1, 0), cA + kstep, voffA); PG8_STAGE(PG8_SB(1, 1), cB + hstep + kstep, voffB);
        PG8_WAIT_V(6); PG8_BAR;
    } else {
        PG8_STAGE(PG8_SB(0, 0), cB, voffB); PG8_STAGE(PG8_SA(0, 0), cA, voffA); PG8_STAGE(PG8_SB(0, 1), cB + hstep, voffB); PG8_STAGE(PG8_SA(0, 1), cA + hstep, voffA);
        if (wr == 1) PG8_BAR;
        PG8_WAIT_V(4); PG8_BAR;
        PG8_STAGE(PG8_SB(1, 0), cB + kstep, voffB); PG8_STAGE(PG8_SA(1, 0), cA + kstep, voffA); PG8_STAGE(PG8_SB(1, 1), cB + hstep + kstep, voffB);
        PG8_WAIT_V(6); PG8_BAR;
    }
    for (;;) {
        const bool has_next = S.next(ui + 1, nxt);
        const char* nA = has_next ? (const char*)g.A + (size_t)nxt.pm * tstep : cA; const char* nB = has_next ? (const char*)g.Bt + (size_t)nxt.pn * tstep : cB;
        for (int t = 0; t < nt; t += 2) {
            const bool last = (t == nt - 2);
            const char* a1 = cA + (size_t)(t + 1) * kstep;
            const char* a2 = last ? nA : cA + (size_t)(t + 2) * kstep; const char* b2 = last ? nB : cB + (size_t)(t + 2) * kstep;
            const char* a3 = a2 + kstep; const char* b3 = b2 + kstep;
            if (last && has_next) S.a_ready(nxt);
            if constexpr (SP2) {
            PG8_LDB(B0, 0, 0); PG8_LDB(B1, 0, 1); PG8_SCHED; PG8_LDA(At, 0, 0); PG8_STAGE(PG8_SA(1, 1), a1 + hstep, voffA);
            PG8_WAIT_V(8); PG8_WAIT_L(0); PG8_BAR; PG8_MMA(0, 0, At, B0); PG8_MMA(0, 1, At, B1); PG8_BAR; PG8_SCHED;
            PG8_LDA(At, 0, 1); PG8_STAGE(PG8_SB(0, 0), b2, voffB); PG8_STAGE(PG8_SB(0, 1), b2 + hstep, voffB); PG8_STAGE(PG8_SA(0, 0), a2, voffA);
            PG8_WAIT_V(8); PG8_WAIT_L(0); PG8_BAR; PG8_MMA(1, 0, At, B0); PG8_MMA(1, 1, At, B1); PG8_BAR; PG8_SCHED;
            PG8_LDB(B0, 1, 0); PG8_LDB(B1, 1, 1); PG8_SCHED; PG8_LDA(At, 1, 0); PG8_STAGE(PG8_SA(0, 1), a2 + hstep, voffA);
            PG8_WAIT_V(8); PG8_WAIT_L(0); PG8_BAR; PG8_MMA(0, 0, At, B0); PG8_MMA(0, 1, At, B1); PG8_BAR; PG8_SCHED;
            PG8_LDA(At, 1, 1); PG8_STAGE(PG8_SB(1, 0), b3, voffB); PG8_STAGE(PG8_SB(1, 1), b3 + hstep, voffB); PG8_STAGE(PG8_SA(1, 0), a3, voffA);
            PG8_WAIT_V(8); PG8_WAIT_L(0); PG8_BAR; PG8_MMA(1, 0, At, B0); PG8_MMA(1, 1, At, B1); PG8_BAR; PG8_SCHED;
            } else {
            PG8_LDB(B0, 0, 0); PG8_SCHED; PG8_LDA(At, 0, 0); PG8_STAGE(PG8_SA(1, 1), a1 + hstep, voffA);
            PG8_WAIT_L(8); PG8_BAR; PG8_WAIT_L(0); PG8_MMA(0, 0, At, B0); PG8_BAR; PG8_SCHED;
            PG8_LDB(B1, 0, 1); PG8_STAGE(PG8_SB(0, 0), b2, voffB);
            PG8_BAR; PG8_WAIT_L(0); PG8_MMA(0, 1, At, B1); PG8_BAR;
            PG8_LDA(At, 0, 1); PG8_STAGE(PG8_SA(0, 0), a2, voffA);
            PG8_BAR; PG8_WAIT_L(0); PG8_MMA(1, 0, At, B0); PG8_BAR; PG8_SCHED;
            PG8_STAGE(PG8_SB(0, 1), b2 + hstep, voffB);
            PG8_WAIT_V(6); PG8_BAR; PG8_MMA(1, 1, At, B1); PG8_BAR;
            PG8_LDB(B0, 1, 0); PG8_SCHED; PG8_LDA(At, 1, 0); PG8_STAGE(PG8_SA(0, 1), a2 + hstep, voffA);
            PG8_WAIT_L(8); PG8_BAR; PG8_WAIT_L(0); PG8_MMA(0, 0, At, B0); PG8_BAR; PG8_SCHED;
            PG8_LDB(B1, 1, 1); PG8_STAGE(PG8_SB(1, 0), b3, voffB);
            PG8_BAR; PG8_WAIT_L(0); PG8_MMA(0, 1, At, B1); PG8_BAR;
            PG8_LDA(At, 1, 1); PG8_STAGE(PG8_SA(1, 0), a3, voffA);
            PG8_BAR; PG8_WAIT_L(0); PG8_MMA(1, 0, At, B0); PG8_BAR; PG8_SCHED;
            PG8_STAGE(PG8_SB(1, 1), b3 + hstep, voffB);
            PG8_WAIT_V(6); PG8_BAR; PG8_MMA(1, 1, At, B1); PG8_BAR;
            }
        }
        if constexpr (ALIGN_EPI) { if (wr == 0) PG8_BAR; }
        if constexpr (!Epi::AFTER_DRAIN) { E(acc, cur, wr, wc, fr, fq); S.done(cur); }
        if (!has_next) break;
#pragma unroll
        for (int a = 0; a < 2; ++a)
#pragma unroll
            for (int b = 0; b < 2; ++b)
#pragma unroll
                for (int m = 0; m < 4; ++m)
#pragma unroll
                    for (int n = 0; n < 2; ++n) acc[a][b][m][n] = (f32x4){0.f, 0.f, 0.f, 0.f};
        cur = nxt; cA = nA; cB = nB; ++ui;
        if constexpr (ALIGN_EPI) { if (wr == 1) PG8_BAR; }
    }
    PG8_WAIT_V(0);
    if constexpr (!ALIGN_EPI) { if (wr == 0) PG8_BAR; }
    PG8_BAR;
    if constexpr (Epi::AFTER_DRAIN) { E.fused(acc, cur, wr, wc, fr, fq, lds, wid, lane); S.done(cur); }
#undef PG8_SA
#undef PG8_SB
#undef PG8_STAGE
#undef PG8_LDA
#undef PG8_LDB
#undef PG8_MMA
#undef PG8_WAIT_V
#undef PG8_WAIT_L
#undef PG8_BAR
#undef PG8_SCHED
}
}


namespace pg8 {
struct Unit2 { int pm, pn; int arow; int e; int r0; int nv; int rtg; };
struct PlainSrc : StaticOrder {
    __device__ __forceinline__ bool next(int i, Unit2& u) const { Unit t; if (!StaticOrder::next(i, t)) return false; u.pm = t.pm; u.pn = t.pn; u.arow = t.pm * BM; u.e = 0; u.r0 = 0; u.nv = BM; u.rtg = 0; return true; }
    static constexpr bool PUBLISH = false; static constexpr int A_AUX = 0; static constexpr size_t A_KSTEP = BK * 2;
    __device__ __forceinline__ void publish(int, int) const {}
    __device__ __forceinline__ void a_issue(const Unit2&, const int (&)[2], int (&)[2][2]) const {}
    __device__ __forceinline__ const char* a_finish(const Gemm& g, const Unit2& u, const int (&R)[2], const int (&C)[2], const int (&)[2][2], unsigned (&v)[2][2]) const {
#pragma unroll
        for (int h = 0; h < 2; ++h)
#pragma unroll
            for (int i = 0; i < 2; ++i) v[h][i] = (unsigned)((h * HALF + R[i]) * g.K + C[i]) * 2u;
        return (const char*)g.A + (size_t)u.arow * g.K * 2;
    }
};
constexpr unsigned HM_STRIPB = 256u * 64u, HM_TILEB = 16u * HM_STRIPB;
constexpr int RDY_STRIDE = 16, RDY_TARGET = 32, RDY_SPIN_CAP = 1 << 22;
template <int STAGE> struct MoeSrc {
    static constexpr bool PUBLISH = (STAGE == 0); static constexpr int A_AUX = 0; static constexpr size_t A_KSTEP = (STAGE == 1) ? 2 * (size_t)HM_STRIPB : (size_t)(BK * 2);
    int G, c, ntn; const int2* list; PG8_LAS int* tab; unsigned* rdy;
    int r8, gapn, q, r9, cc, hasgap;
    __device__ __forceinline__ void init(const unsigned* cnt, PG8_LAS int* tab_, int G_, int c_, int ntn_, const int2* list_, unsigned* rdy_, int wid) {
        G = G_; c = c_; ntn = ntn_; list = list_; tab = tab_; rdy = rdy_;
        if constexpr (STAGE == 0) {
        if (wid == 0) { const int lane = (int)__builtin_amdgcn_mbcnt_hi(~0u, __builtin_amdgcn_mbcnt_lo(~0u, 0u));
            const int a = (lane < 32) ? (int)__hip_atomic_load(cnt + lane, __ATOMIC_RELAXED, __HIP_MEMORY_SCOPE_AGENT) : 0, t4 = ((a + BM - 1) / BM) * ntn_;
            int ia = a, it = t4;
#pragma unroll
            for (int o = 1; o < 32; o <<= 1) { const int x = __shfl_up(ia, o), y = __shfl_up(it, o); if ((lane & 31) >= o) { ia += x; it += y; } }
            if (lane < 32) { tab_[4 * lane] = a; tab_[4 * lane + 1] = ia - a; tab_[4 * lane + 2] = it; tab_[4 * lane + 3] = it - t4; } }
        __syncthreads();
        r8 = gapn = q = r9 = cc = hasgap = 0;
        } else {
            const int n = __builtin_amdgcn_readfirstlane(tab_[4 * 31 + 2]);
            r8 = n % G_; const int gap = r8 ? G_ - r8 : 0; gapn = gap < n ? gap : n; const int n9 = n - gapn; q = n9 / G_; r9 = n9 - q * G_;
            cc = r8 ? (c_ - r8 + G_) % G_ : c_; hasgap = (r8 > 0 && c_ >= r8 && c_ - r8 < n) ? 1 : 0;
        }
    }
    __device__ __forceinline__ bool next(int i, Unit2& u) const {
        const int total = tab[4 * 31 + 2]; int L;
        if constexpr (STAGE == 0) { L = i * G + c; if (L >= total) return false; }
        else { int ii = i - hasgap;
            if (ii < 0) L = c - r8; else if (ii < q) L = gapn + ii * G + c; else if (ii == q && cc < r9) L = gapn + q * G + cc; else return false; }
        const int lane = (int)__builtin_amdgcn_mbcnt_hi(~0u, __builtin_amdgcn_mbcnt_lo(~0u, 0u)); const int inc = tab[4 * (lane & 31) + 2];
        const unsigned long long m = __ballot(lane < 32 && L >= inc); const int e = __builtin_amdgcn_readfirstlane(__popcll(m));
        const int cnt = __builtin_amdgcn_readfirstlane(tab[4 * e]), ex = __builtin_amdgcn_readfirstlane(tab[4 * e + 1]), ux = __builtin_amdgcn_readfirstlane(tab[4 * e + 3]), l0 = L - ux;
        const int rt = l0 / ntn, pn = l0 - rt * ntn;
        u.e = e; u.pm = rt; u.pn = e * ntn + pn; u.r0 = rt * BM; u.nv = (cnt - rt * BM) < BM ? (cnt - rt * BM) : BM; u.arow = ex + rt * BM; u.rtg = ux / ntn + rt; return true;
    }
    __device__ __forceinline__ void publish(int rtg, int lane) const { if (lane == 0) (void)__hip_atomic_fetch_add(rdy + rtg * RDY_STRIDE, 1u, __ATOMIC_RELAXED, __HIP_MEMORY_SCOPE_AGENT); }
    __device__ __forceinline__ void a_issue(const Unit2& u, const int (&R)[2], int (&aid)[2][2]) const {
        if constexpr (STAGE == 0) {
#pragma unroll
            for (int h = 0; h < 2; ++h)
#pragma unroll
                for (int i = 0; i < 2; ++i) { int r = h * HALF + R[i]; r = r < u.nv ? r : u.nv - 1; aid[h][i] = list[u.e * 32768 + u.r0 + r].x; }
        } else aid[0][0] = (int)__hip_atomic_load(rdy + u.rtg * RDY_STRIDE, __ATOMIC_RELAXED, __HIP_MEMORY_SCOPE_AGENT);
    }
    __device__ __forceinline__ const char* a_finish(const Gemm& g, const Unit2& u, const int (&R)[2], const int (&C)[2], const int (&aid)[2][2], unsigned (&v)[2][2]) const {
        if constexpr (STAGE == 0) {
#pragma unroll
            for (int h = 0; h < 2; ++h)
#pragma unroll
                for (int i = 0; i < 2; ++i) v[h][i] = ((unsigned)(aid[h][i] >> 1) * (unsigned)g.K + (unsigned)C[i]) * 2u;
            return (const char*)g.A;
        } else {
            int seen = __builtin_amdgcn_readfirstlane(aid[0][0]);
            if (seen < RDY_TARGET) { int sp = 0;
                do { __builtin_amdgcn_s_sleep(2); seen = __builtin_amdgcn_readfirstlane((int)__hip_atomic_load(rdy + u.rtg * RDY_STRIDE, __ATOMIC_RELAXED, __HIP_MEMORY_SCOPE_AGENT)); } while (seen < RDY_TARGET && ++sp < RDY_SPIN_CAP); }
#pragma unroll
            for (int h = 0; h < 2; ++h)
#pragma unroll
                for (int i = 0; i < 2; ++i) { int r = h * HALF + R[i]; r = r < u.nv ? r : u.nv - 1; v[h][i] = (unsigned)(C[i] >> 5) * HM_STRIPB + (unsigned)(r * 64 + (C[i] & 31) * 2); }
            return (const char*)g.A + (size_t)u.rtg * HM_TILEB;
        }
    }
};
__device__ __forceinline__ void unpack8(const u32x4 w, f32x4& a, f32x4& b) { a[0] = __uint_as_float(w.x << 16); a[1] = __uint_as_float(w.x & 0xffff0000u); a[2] = __uint_as_float(w.y << 16); a[3] = __uint_as_float(w.y & 0xffff0000u);
    b[0] = __uint_as_float(w.z << 16); b[1] = __uint_as_float(w.z & 0xffff0000u); b[2] = __uint_as_float(w.w << 16); b[3] = __uint_as_float(w.w & 0xffff0000u); }
template <bool ACCUM> struct EpiGate {
    static constexpr bool PERM = true, AFTER_DRAIN = false, HAS_MID = false;
    bf16_t* MGp; const bf16_t* Gp; int goff;
    __device__ __forceinline__ void operator()(const f32x4 (&acc)[2][2][4][2], const Unit2& u, int wr, int wc, int fr, int fq) const {
        const int row0 = u.pm * BM + wr * 64 + fr, col0 = (u.pn & 3) * BM + wc * 32 + 8 * fq;
#pragma unroll
        for (int ai = 0; ai < 2; ++ai)
#pragma unroll
        for (int mh = 0; mh < (ACCUM ? 2 : 1); ++mh) {
            constexpr int MB = ACCUM ? 2 : 4; const int m0 = mh * MB;
            u32x4 gw[4][2], ow[4][2];
#pragma unroll
            for (int m = m0; m < m0 + MB; ++m) { const size_t t = (size_t)(row0 + ai * HALF + m * 16);
#pragma unroll
                for (int bj = 0; bj < 2; ++bj) { gw[m][bj] = *(const u32x4*)(Gp + t * 2048 + goff + col0 + bj * HALF); if (ACCUM) ow[m][bj] = *(const u32x4*)(MGp + t * 1024 + col0 + bj * HALF); } }
#pragma unroll
            for (int m = m0; m < m0 + MB; ++m) { const size_t t = (size_t)(row0 + ai * HALF + m * 16);
#pragma unroll
                for (int bj = 0; bj < 2; ++bj) { f32x4 g0, g1; unpack8(gw[m][bj], g0, g1);
                    f32x4 v0 = acc[ai][bj][m][0] * g0, v1 = acc[ai][bj][m][1] * g1;
                    if (ACCUM) { f32x4 o0, o1; unpack8(ow[m][bj], o0, o1); v0 += o0; v1 += o1; }
                    *(u32x4*)(MGp + t * 1024 + col0 + bj * HALF) = pack8(v0, v1); } } }
    }
};
struct EpiMerge {
    static constexpr bool PERM = true, AFTER_DRAIN = false, HAS_MID = true;
    bf16_t* MGp; const bf16_t* Gp;
    __device__ __forceinline__ void mid(f32x4 (&acc)[2][2][4][2], const Unit2& u, int wr, int wc, int fr, int fq) const {
        int row0 = u.pm * BM + wr * 64 + fr, col0 = (u.pn & 3) * BM + wc * 32 + 8 * fq; asm volatile("" : "+v"(row0), "+v"(col0));
#pragma unroll
        for (int ai = 0; ai < 2; ++ai) {
            u32x4 g0w[4][2], g1w[4][2];
#pragma unroll
            for (int m = 0; m < 4; ++m) { const size_t t = (size_t)(row0 + ai * HALF + m * 16);
#pragma unroll
                for (int bj = 0; bj < 2; ++bj) { g0w[m][bj] = *(const u32x4*)(Gp + t * 2048 + col0 + bj * HALF); g1w[m][bj] = *(const u32x4*)(Gp + t * 2048 + 1024 + col0 + bj * HALF); } }
#pragma unroll
            for (int m = 0; m < 4; ++m)
#pragma unroll
                for (int bj = 0; bj < 2; ++bj) { f32x4 a0, a1, b0, b1; unpack8(g0w[m][bj], a0, a1); unpack8(g1w[m][bj], b0, b1);
#pragma unroll
                    for (int e = 0; e < 4; ++e) { acc[ai][bj][m][0][e] *= b0[e] * __builtin_amdgcn_rcpf(__builtin_fmaxf(a0[e], 9.5367431640625e-07f)); acc[ai][bj][m][1][e] *= b1[e] * __builtin_amdgcn_rcpf(__builtin_fmaxf(a1[e], 9.5367431640625e-07f)); } }
            asm volatile("" ::: "memory"); }
    }
    __device__ __forceinline__ void operator()(const f32x4 (&acc)[2][2][4][2], const Unit2& u, int wr, int wc, int fr, int fq) const {
        const int row0 = u.pm * BM + wr * 64 + fr, col0 = (u.pn & 3) * BM + wc * 32 + 8 * fq;
#pragma unroll
        for (int ai = 0; ai < 2; ++ai) {
            u32x4 g0w[4][2];
#pragma unroll
            for (int m = 0; m < 4; ++m)
#pragma unroll
                for (int bj = 0; bj < 2; ++bj) g0w[m][bj] = *(const u32x4*)(Gp + (size_t)(row0 + ai * HALF + m * 16) * 2048 + col0 + bj * HALF);
#pragma unroll
            for (int m = 0; m < 4; ++m)
#pragma unroll
                for (int bj = 0; bj < 2; ++bj) { f32x4 a0, a1; unpack8(g0w[m][bj], a0, a1);
#pragma unroll
                    for (int e = 0; e < 4; ++e) { a0[e] = __builtin_fmaxf(a0[e], 9.5367431640625e-07f); a1[e] = __builtin_fmaxf(a1[e], 9.5367431640625e-07f); }
                    *(u32x4*)(MGp + (size_t)(row0 + ai * HALF + m * 16) * 1024 + col0 + bj * HALF) = pack8(acc[ai][bj][m][0] * a0, acc[ai][bj][m][1] * a1); } }
    }
};
struct EpiRes {
    static constexpr bool PERM = false, AFTER_DRAIN = false, HAS_MID = false;
    const float* x; float* out; float alpha;
    __device__ __forceinline__ void operator()(const f32x4 (&acc)[2][2][4][2], const Unit2& u, int wr, int wc, int fr, int fq) const {
        const int row0 = u.pm * BM + wr * 64 + fr, col0 = u.pn * BM + wc * 32 + 4 * fq;
#pragma unroll
        for (int ai = 0; ai < 2; ++ai)
#pragma unroll
            for (int m = 0; m < 4; ++m) { const size_t off = (size_t)(row0 + ai * HALF + m * 16) * 1024 + col0;
#pragma unroll
                for (int bj = 0; bj < 2; ++bj)
#pragma unroll
                    for (int n = 0; n < 2; ++n) { const f32x4 xv = *(const f32x4*)(x + off + bj * HALF + n * 16); *(f32x4*)(out + off + bj * HALF + n * 16) = xv * alpha + acc[ai][bj][m][n]; } }
    }
};
struct EpiResB {
    static constexpr bool PERM = true, AFTER_DRAIN = false, HAS_MID = false;
    bf16_t* xb; float alpha;
    __device__ __forceinline__ void operator()(const f32x4 (&acc)[2][2][4][2], const Unit2& u, int wr, int wc, int fr, int fq) const {
        const int row0 = u.pm * BM + wr * 64 + fr, col0 = u.pn * BM + wc * 32 + 8 * fq;
#pragma unroll
        for (int ai = 0; ai < 2; ++ai) {
            u32x4 xw[4][2];
#pragma unroll
            for (int m = 0; m < 4; ++m)
#pragma unroll
                for (int bj = 0; bj < 2; ++bj) xw[m][bj] = *(const u32x4*)(xb + (size_t)(row0 + ai * HALF + m * 16) * 1024 + col0 + bj * HALF);
#pragma unroll
            for (int m = 0; m < 4; ++m) { bf16_t* p = xb + (size_t)(row0 + ai * HALF + m * 16) * 1024 + col0;
#pragma unroll
                for (int bj = 0; bj < 2; ++bj) { f32x4 x0, x1; unpack8(xw[m][bj], x0, x1);
                    *(u32x4*)(p + bj * HALF) = pack8(x0 * alpha + acc[ai][bj][m][0], x1 * alpha + acc[ai][bj][m][1]); } } }
    }
};
struct EpiSwiglu {
    static constexpr bool PERM = true, AFTER_DRAIN = false, HAS_MID = false;
    bf16_t* HMp;
    __device__ __forceinline__ void operator()(const f32x4 (&acc)[2][2][4][2], const Unit2& u, int wr, int wc, int fr, int fq) const {
        const int rl0 = wr * 64 + fr, col0 = (u.pn & 3) * 128 + wc * 32 + 8 * fq;
        const __amdgpu_buffer_rsrc_t rs = __builtin_amdgcn_make_buffer_rsrc((void*)HMp, 0, 0x7ffffff0, 0x00020000);
#pragma unroll
        for (int ai = 0; ai < 2; ++ai)
#pragma unroll
            for (int m = 0; m < 4; ++m) { const int rl = rl0 + ai * HALF + m * 16;
                if (rl < u.nv) { f32x4 h0, h1;
#pragma unroll
                    for (int e = 0; e < 4; ++e) { const float g0 = acc[ai][0][m][0][e], g1 = acc[ai][0][m][1][e];
                        h0[e] = g0 * sigmoidf_fast(g0) * acc[ai][1][m][0][e]; h1[e] = g1 * sigmoidf_fast(g1) * acc[ai][1][m][1][e]; }
                    __builtin_amdgcn_raw_buffer_store_b128(pack8(h0, h1), rs, (unsigned)u.rtg * HM_TILEB + (unsigned)(col0 >> 5) * HM_STRIPB + (unsigned)(rl * 64 + (col0 & 31) * 2), 0, 16); } }
    }
};
struct EpiDown {
    static constexpr bool PERM = true, AFTER_DRAIN = false, HAS_MID = false;
    bf16_t* YSp; const int2* list;
    __device__ __forceinline__ void operator()(const f32x4 (&acc)[2][2][4][2], const Unit2& u, int wr, int wc, int fr, int fq) const {
        const int rl0 = wr * 64 + fr, col0 = (u.pn & 3) * BM + wc * 32 + 8 * fq;
        int aid[2][4]; float w[2][4];
#pragma unroll
        for (int ai = 0; ai < 2; ++ai)
#pragma unroll
            for (int m = 0; m < 4; ++m) { int rl = rl0 + ai * HALF + m * 16; rl = rl < u.nv ? rl : u.nv - 1; const int2 en = list[u.e * 32768 + u.r0 + rl]; aid[ai][m] = en.x; w[ai][m] = __int_as_float(en.y); }
#pragma unroll
        for (int ai = 0; ai < 2; ++ai)
#pragma unroll
            for (int m = 0; m < 4; ++m) { const int rl = rl0 + ai * HALF + m * 16;
                if (rl < u.nv) { bf16_t* p = YSp + (size_t)aid[ai][m] * 1024 + col0;
#pragma unroll
                    for (int bj = 0; bj < 2; ++bj) *(u32x4*)(p + bj * HALF) = pack8(acc[ai][bj][m][0] * w[ai][m], acc[ai][bj][m][1] * w[ai][m]); } }
    }
};
template <class Epi, class Sched, bool ALIGN_EPI = true>
__device__ __forceinline__ void gemm_phase2(PG8_LAS unsigned char* lds, const Gemm g, const Sched& S, const Epi& E, const int wid_in) {
    constexpr bool SP2 = true;
    int tid_ = wid_in * 64 + (int)__builtin_amdgcn_mbcnt_hi(~0u, __builtin_amdgcn_mbcnt_lo(~0u, 0u)); asm volatile("" : "+v"(tid_));
    const int tid = tid_, wid = __builtin_amdgcn_readfirstlane(tid >> 6), lane = tid & 63, wr = wid >> 2, wc = wid & 3, fr = lane & 15, fq = lane >> 4;
    const int K = g.K, nt = K / BK;
    unsigned voffB[2]; int RA[2], CA[2];
#pragma unroll
    for (int i = 0; i < 2; ++i) { int R, C; stage_rc(tid * 16 + i * 8192, R, C); const int Rb = Epi::PERM ? ((R & ~31) + perm32(R & 31)) : R;
        RA[i] = R; CA[i] = C; voffB[i] = (unsigned)(Rb * K + C) * 2u; }
    const size_t kstep = (size_t)(BK * 2);
    const size_t kstepA = Sched::A_KSTEP;
    const size_t hstep = (size_t)HALF * K * 2;
    const size_t tstep = 2 * hstep;
    const unsigned ldsw = (unsigned)wid * 1024u;
    const int aoff = lds_byte(wr * 64 + fr, fq * 8), boff = lds_byte(wc * 32 + fr, fq * 8);
#define PG8_SA(b, h) (((b) * 2 + (h)) * HTB)
#define PG8_SB(b, h) ((4 + (b) * 2 + (h)) * HTB)
#define PG8_STAGE(bufoff, gbase, voff) do { _Pragma("unroll") for (int _i = 0; _i < 2; ++_i) \
        __builtin_amdgcn_global_load_lds((const unsigned*)((const char*)(gbase) + (voff)[_i]), (PG8_LAS unsigned*)(lds + (bufoff) + ldsw + _i * 8192), 16, 0, 0); } while (0)
#define PG8_STAGEA(bufoff, gbase, voff) do { _Pragma("unroll") for (int _i = 0; _i < 2; ++_i) \
        __builtin_amdgcn_global_load_lds((const unsigned*)((const char*)(gbase) + (voff)[_i]), (PG8_LAS unsigned*)(lds + (bufoff) + ldsw + _i * 8192), 16, 0, Sched::A_AUX); } while (0)
#define PG8_LDA(dst, b, h) do { _Pragma("unroll") for (int m = 0; m < 4; ++m) _Pragma("unroll") for (int k = 0; k < 2; ++k) dst[m][k] = *(const PG8_LAS bf16x8*)(lds + PG8_SA(b, h) + aoff + m * 2048 + k * 1024); } while (0)
#define PG8_LDB(dst, b, h) do { _Pragma("unroll") for (int n = 0; n < 2; ++n) _Pragma("unroll") for (int k = 0; k < 2; ++k) dst[n][k] = *(const PG8_LAS bf16x8*)(lds + PG8_SB(b, h) + boff + n * 2048 + k * 1024); } while (0)
#define PG8_MMA(ai, bj, At, Bt) do { __builtin_amdgcn_s_setprio(1); _Pragma("unroll") for (int m = 0; m < 4; ++m) _Pragma("unroll") for (int n = 0; n < 2; ++n) _Pragma("unroll") for (int k = 0; k < 2; ++k) \
        acc[ai][bj][m][n] = __builtin_amdgcn_mfma_f32_16x16x32_bf16(Bt[n][k], At[m][k], acc[ai][bj][m][n], 0, 0, 0); __builtin_amdgcn_s_setprio(0); } while (0)
#define PG8_WAIT_V(n) asm volatile("s_waitcnt vmcnt(" #n ")" ::: "memory")
#define PG8_WAIT_L(n) asm volatile("s_waitcnt lgkmcnt(" #n ")" ::: "memory")
#define PG8_BAR __builtin_amdgcn_s_barrier()
#define PG8_SCHED __builtin_amdgcn_sched_barrier(0)
    Unit2 cur, nxt; int ui = 0; int pend = -1;
    if (!S.next(0, cur)) return;
    f32x4 acc[2][2][4][2];
#pragma unroll
    for (int a = 0; a < 2; ++a)
#pragma unroll
        for (int b = 0; b < 2; ++b)
#pragma unroll
            for (int m = 0; m < 4; ++m)
#pragma unroll
                for (int n = 0; n < 2; ++n) acc[a][b][m][n] = (f32x4){0.f, 0.f, 0.f, 0.f};
    bf16x8 At[4][2], B0[2][2], B1[2][2];
    unsigned cvA[2][2];
    const char* cA; { int aid0[2][2]; S.a_issue(cur, RA, aid0); cA = S.a_finish(g, cur, RA, CA, aid0, cvA); } const char* cB = (const char*)g.Bt + (size_t)cur.pn * tstep;
    if constexpr (SP2) {
        PG8_STAGE(PG8_SB(0, 0), cB, voffB); PG8_STAGE(PG8_SB(0, 1), cB + hstep, voffB); PG8_STAGEA(PG8_SA(0, 0), cA, cvA[0]); PG8_STAGEA(PG8_SA(0, 1), cA, cvA[1]);
        if (wr == 1) PG8_BAR;
        PG8_WAIT_V(2); PG8_BAR;
        PG8_STAGE(PG8_SB(1, 0), cB + kstep, voffB); PG8_STAGEA(PG8_SA(1, 0), cA + kstepA, cvA[0]); PG8_STAGE(PG8_SB(1, 1), cB + hstep + kstep, voffB);
        PG8_WAIT_V(6); PG8_BAR;
    }
    for (;;) {
        const bool has_next = S.next(ui + 1, nxt);
        const char* nA = cA; const char* nB = has_next ? (const char*)g.Bt + (size_t)nxt.pn * tstep : cB;
        for (int t = 0; t < nt; t += 2) {
            const bool last = (t == nt - 2);
            const char* a1 = cA + (size_t)(t + 1) * kstepA;
            int aidn[2][2] = {{0, 0}, {0, 0}};
            if constexpr (Sched::PUBLISH) { if (t == 2 && pend >= 0) { S.publish(pend, lane); pend = -1; } }
            if constexpr (Epi::HAS_MID) { if (t == nt / 2) { PG8_SCHED; E.mid(acc, cur, wr, wc, fr, fq); PG8_SCHED; } }
            if (last && has_next) S.a_issue(nxt, RA, aidn);
            if constexpr (SP2) {
            PG8_LDB(B0, 0, 0); PG8_LDB(B1, 0, 1); PG8_SCHED; PG8_LDA(At, 0, 0); PG8_STAGEA(PG8_SA(1, 1), a1, cvA[1]);
            PG8_WAIT_V(8); PG8_WAIT_L(0); PG8_BAR; PG8_MMA(0, 0, At, B0); PG8_MMA(0, 1, At, B1); PG8_BAR; PG8_SCHED;
            if (last && has_next) nA = S.a_finish(g, nxt, RA, CA, aidn, cvA);
            const char* a2 = last ? nA : cA + (size_t)(t + 2) * kstepA; const char* b2 = last ? nB : cB + (size_t)(t + 2) * kstep;
            const char* a3 = a2 + kstepA; const char* b3 = b2 + kstep;
            PG8_LDA(At, 0, 1); PG8_STAGE(PG8_SB(0, 0), b2, voffB); PG8_STAGE(PG8_SB(0, 1), b2 + hstep, voffB); PG8_STAGEA(PG8_SA(0, 0), a2, cvA[0]);
            PG8_WAIT_V(8); PG8_WAIT_L(0); PG8_BAR; PG8_MMA(1, 0, At, B0); PG8_MMA(1, 1, At, B1); PG8_BAR; PG8_SCHED;
            PG8_LDB(B0, 1, 0); PG8_LDB(B1, 1, 1); PG8_SCHED; PG8_LDA(At, 1, 0); PG8_STAGEA(PG8_SA(0, 1), a2, cvA[1]);
            PG8_WAIT_V(8); PG8_WAIT_L(0); PG8_BAR; PG8_MMA(0, 0, At, B0); PG8_MMA(0, 1, At, B1); PG8_BAR; PG8_SCHED;
            PG8_LDA(At, 1, 1); PG8_STAGE(PG8_SB(1, 0), b3, voffB); PG8_STAGE(PG8_SB(1, 1), b3 + hstep, voffB); PG8_STAGEA(PG8_SA(1, 0), a3, cvA[0]);
            PG8_WAIT_V(8); PG8_WAIT_L(0); PG8_BAR; PG8_MMA(1, 0, At, B0); PG8_MMA(1, 1, At, B1); PG8_BAR; PG8_SCHED;
            }
        }
        if constexpr (ALIGN_EPI) { if (wr == 0) PG8_BAR; }
        E(acc, cur, wr, wc, fr, fq);
        if constexpr (Sched::PUBLISH) pend = cur.rtg;
        if (!has_next) break;
#pragma unroll
        for (int a = 0; a < 2; ++a)
#pragma unroll
            for (int b = 0; b < 2; ++b)
#pragma unroll
                for (int m = 0; m < 4; ++m)
#pragma unroll
                    for (int n = 0; n < 2; ++n) acc[a][b][m][n] = (f32x4){0.f, 0.f, 0.f, 0.f};
        cur = nxt; cA = nA; cB = nB; ++ui;
        if constexpr (ALIGN_EPI) { if (wr == 1) PG8_BAR; }
    }
    PG8_WAIT_V(0);
    if constexpr (Sched::PUBLISH) { if (pend >= 0) S.publish(pend, lane); }
    if constexpr (!ALIGN_EPI) { if (wr == 0) PG8_BAR; }
    PG8_BAR;
#undef PG8_SA
#undef PG8_SB
#undef PG8_STAGE
#undef PG8_STAGEA
#undef PG8_LDA
#undef PG8_LDB
#undef PG8_MMA
#undef PG8_WAIT_V
#undef PG8_WAIT_L
#undef PG8_BAR
#undef PG8_SCHED
}

}
#include <hip/hip_bf16.h>

#define ATTN_STORE16(p,v) (*(u32x4*)(p)=(v))
namespace attn_b {
using bf16=__hip_bfloat16;
using bf16x8=__attribute__((ext_vector_type(8)))short;
using s16x4=__attribute__((ext_vector_type(4)))short;
using f32x16=__attribute__((ext_vector_type(16)))float;
using u32x4=__attribute__((ext_vector_type(4)))unsigned;
constexpr int BATCH=4,SEQ=8192,D=64,QP=512,KP=512,VP=512,OP=1024;
constexpr int NW=8,QBLK=32,QB=QBLK*NW,KVBLK=64,NQB=SEQ/QB;
constexpr int ATTN_UNIT_ROWS=QB;
__device__ __forceinline__ int crow(int r,int hi){return (r&3)+8*(r>>2)+4*hi;}
#define SBAR() __builtin_amdgcn_sched_barrier(0)
__device__ __forceinline__ void cmask(f32x16&p0,f32x16&p1,int jb,int qrel,int hi){
  const float NEG=-INFINITY; int kb=64*jb+4*hi;
  #pragma unroll
  for(int r=0;r<16;++r){int kv=kb+(r&3)+8*(r>>2); if(kv>qrel)p0[r]=NEG; if(kv+32>qrel)p1[r]=NEG;}
}

constexpr int NSLOT=3, SLOTB=8192;
constexpr int LDS_K=0, LDS_V=NSLOT*SLOTB, LDS_WS=3*NSLOT*SLOTB, LDS_OST=LDS_WS+NW*64*4, LDS_BYTES=LDS_OST+NW*4096;
constexpr float C2=0.125f*1.4426950408889634f;
__device__ __forceinline__ void glds16(const void*gbase,unsigned voff,unsigned lds_dst){unsigned keep;
  asm volatile("s_mov_b32 %0, m0\n\ts_mov_b32 m0, %3\n\ts_nop 0\n\tglobal_load_lds_dwordx4 %1, %2\n\ts_mov_b32 m0, %0":"=&s"(keep):"v"(voff),"s"(gbase),"s"(lds_dst):"memory");}
__device__ __forceinline__ float max3f(float a,float b,float c){float r;asm("v_max3_f32 %0, %1, %2, %3":"=v"(r):"v"(a),"v"(b),"v"(c));return r;}
__device__ __forceinline__ float max2f(float a,float b){float r;asm("v_max_f32_e32 %0, %1, %2":"=v"(r):"v"(a),"v"(b));return r;}
__device__ __forceinline__ float fadd_s(float a,float b){float r;asm("v_add_f32_e32 %0, %1, %2":"=v"(r):"v"(a),"v"(b));return r;}
__device__ __forceinline__ float fsub_s(float a,float b){float r;asm("v_sub_f32_e32 %0, %1, %2":"=v"(r):"v"(a),"v"(b));return r;}
typedef float f32x2_t __attribute__((ext_vector_type(2))); typedef __bf16 bf16x2_t __attribute__((ext_vector_type(2)));
__device__ __forceinline__ unsigned cvtpk_s(float lo,float hi){f32x2_t v={lo,hi};bf16x2_t b=__builtin_convertvector(v,bf16x2_t);return __builtin_bit_cast(unsigned,b);}
#define WAIT_BAR(N) asm volatile("s_waitcnt vmcnt(" #N ") lgkmcnt(0)\n\ts_barrier":::"memory")

__device__ __forceinline__ void qkt(f32x16&p0,f32x16&p1,const char*Kslot,const bf16x8*qr,int r32,int hi){ const f32x16 zz=f32x16{};
  const char*kb=Kslot+hi*1024+r32*16;
  #pragma unroll
  for(int d0=0;d0<4;++d0){
    const bf16x8 b0=*reinterpret_cast<const bf16x8*>(kb+d0*2048);
    const bf16x8 b1=*reinterpret_cast<const bf16x8*>(kb+d0*2048+512);
    if(d0==0){p0=__builtin_amdgcn_mfma_f32_32x32x16_bf16(b0,qr[0],zz,0,0,0);p1=__builtin_amdgcn_mfma_f32_32x32x16_bf16(b1,qr[0],zz,0,0,0);}
    else{p0=__builtin_amdgcn_mfma_f32_32x32x16_bf16(b0,qr[d0],p0,0,0,0);p1=__builtin_amdgcn_mfma_f32_32x32x16_bf16(b1,qr[d0],p1,0,0,0);}}
}
typedef __attribute__((address_space(3))) const char* lds_cptr;
typedef short v4i16_t __attribute__((ext_vector_type(4)));
__device__ __forceinline__ void kload8(bf16x8*kf,lds_cptr kp){
  kf[0]=*(const __attribute__((address_space(3))) bf16x8*)(kp);      kf[1]=*(const __attribute__((address_space(3))) bf16x8*)(kp+512);
  kf[2]=*(const __attribute__((address_space(3))) bf16x8*)(kp+2048); kf[3]=*(const __attribute__((address_space(3))) bf16x8*)(kp+2560);
  kf[4]=*(const __attribute__((address_space(3))) bf16x8*)(kp+4096); kf[5]=*(const __attribute__((address_space(3))) bf16x8*)(kp+4608);
  kf[6]=*(const __attribute__((address_space(3))) bf16x8*)(kp+6144); kf[7]=*(const __attribute__((address_space(3))) bf16x8*)(kp+6656);
}
__device__ __forceinline__ void kload2(bf16x8*kf,lds_cptr kp,int j){ kf[2*j]=*(const __attribute__((address_space(3))) bf16x8*)(kp+j*2048); kf[2*j+1]=*(const __attribute__((address_space(3))) bf16x8*)(kp+j*2048+512); }
__device__ __forceinline__ s16x4 vtr(lds_cptr p){ return __builtin_bit_cast(s16x4,__builtin_amdgcn_ds_read_tr16_b64_v4i16((__attribute__((address_space(3))) v4i16_t*)p)); }
__device__ __forceinline__ float rowmax(const f32x16&p0,const f32x16&p1){
  float a=max3f(p0[0],p0[1],p1[0]),b=max3f(p0[2],p0[3],p1[1]);a=max3f(a,p1[2],p1[3]);
  #pragma unroll
  for(int r=4;r<16;r+=4){a=max3f(a,p0[r],p0[r+1]);b=max3f(b,p0[r+2],p0[r+3]);a=max3f(a,p1[r],p1[r+1]);b=max3f(b,p1[r+2],p1[r+3]);}
  const float m=max2f(a,b);
  auto rr=__builtin_amdgcn_permlane32_swap(__float_as_uint(m),__float_as_uint(m),false,false);
  return max2f(__uint_as_float(rr[0]),__uint_as_float(rr[1]));
}
__device__ __forceinline__ void pv(f32x16*o,int vb,bf16x8 pa0,bf16x8 pa1,bf16x8 pa2,bf16x8 pa3){
  #pragma unroll
  for(int d0=0;d0<4;++d0){s16x4 lo[4],hi[4];
    #pragma unroll
    for(int ks=0;ks<4;++ks){
      asm volatile("ds_read_b64_tr_b16 %0,%1 offset:%c2":"=&v"(lo[ks]):"v"(vb),"i"(d0*4096+ks*1024):"memory");
      asm volatile("ds_read_b64_tr_b16 %0,%1 offset:%c2":"=&v"(hi[ks]):"v"(vb),"i"(d0*4096+ks*1024+512):"memory");}
    asm volatile("s_waitcnt lgkmcnt(0)":::"memory");SBAR();
    #define PK(k) (bf16x8){lo[k][0],lo[k][1],lo[k][2],lo[k][3],hi[k][0],hi[k][1],hi[k][2],hi[k][3]}
    o[d0]=__builtin_amdgcn_mfma_f32_32x32x16_bf16(pa0,PK(0),o[d0],0,0,0);
    o[d0]=__builtin_amdgcn_mfma_f32_32x32x16_bf16(pa1,PK(1),o[d0],0,0,0);
    o[d0]=__builtin_amdgcn_mfma_f32_32x32x16_bf16(pa2,PK(2),o[d0],0,0,0);
    o[d0]=__builtin_amdgcn_mfma_f32_32x32x16_bf16(pa3,PK(3),o[d0],0,0,0);
    #undef PK
  }
}

template<int THRL> __device__ __forceinline__ void attn_unit(int b,int qc,int kc,int vc,int oc,int qb,const bf16*Q,const bf16*__restrict__ K,const bf16*__restrict__ V,bf16*O,char*shm,const int wid){
  const int lane=(int)__builtin_amdgcn_mbcnt_hi(~0u,__builtin_amdgcn_mbcnt_lo(~0u,0u)),r32=lane&31,hi=lane>>5;
  const long rowbase=(long)b*SEQ; const int q0=qb*QB;
  const bf16*Qw=Q+(rowbase+q0+wid*QBLK)*QP+qc;
  const bf16*Kh=K+rowbase*KP+kc,*Vh=V+rowbase*VP+vc;
  const unsigned lds0=(unsigned)(uintptr_t)shm;
  float*wsf=(float*)(shm+LDS_WS)+wid*64;
  const bf16*ksrc=Kh+wid*8; const unsigned koff=(unsigned)(lane*KP*2);
  const bf16*vsrc=Vh+(long)(16*(wid&3))*VP+(wid>>2)*32; const unsigned voff=(unsigned)(((lane>>2)*VP+(lane&3)*8)*2);
  const unsigned kdst=lds0+LDS_K+wid*1024, vdst=lds0+LDS_V+wid*1024;
  #define DMA_K(t,slot) glds16(ksrc+(long)(t)*KVBLK*KP,koff,(unsigned)__builtin_amdgcn_readfirstlane(kdst+(slot)))
  #define DMA_V(t,slot) do{ glds16(vsrc+(long)(t)*KVBLK*VP,voff,(unsigned)__builtin_amdgcn_readfirstlane(vdst+2*(slot))); glds16(vsrc+(long)(t)*KVBLK*VP+64,voff,(unsigned)__builtin_amdgcn_readfirstlane(vdst+2*(slot)+8192)); }while(0)
  const int vb0=(int)(lds0+LDS_V)+((lane>>4)&1)*32+(lane&3)*8+(4*hi+((lane&15)>>2))*64;
  const char*Kbase=shm+LDS_K; bf16x8 kf[8];
  const lds_cptr shm3=(lds_cptr)shm; const lds_cptr kp0=shm3+LDS_K+hi*1024+r32*16; const lds_cptr vp0=shm3+LDS_V+((lane>>4)&1)*32+(lane&3)*8+(4*hi+((lane&15)>>2))*64;
  const int NT=(q0+QB)/KVBLK;
  DMA_K(0,0);DMA_V(0,0);DMA_K(1,SLOTB);
  bf16x8 qr[4];
  #pragma unroll
  for(int d0=0;d0<4;++d0)qr[d0]=*reinterpret_cast<const bf16x8*>(&Qw[(long)r32*QP+d0*16+hi*8]);
  float mhat=0.f,l_reg=0.f;f32x16 o[4];o[0]=f32x16{};o[1]=f32x16{};o[2]=f32x16{};o[3]=f32x16{};const f32x16 zz=f32x16{};
  const int qrel=wid*QBLK+r32;
  #define CMASK(P0,P1,t) do{int jb_=(t)-(NT-4); if(jb_>=0)cmask(P0,P1,jb_,qrel,hi);}while(0)
  bool resc=false;
  #define START(P0,P1) do{ const float rm=rowmax(P0,P1); resc=false; mhat=rm; \
    _Pragma("unroll") for(int r=0;r<16;++r)P0[r]=__builtin_amdgcn_exp2f(fsub_s(P0[r],mhat)); }while(0)
  #define RESC() do{ if(resc){ asm volatile("s_waitcnt lgkmcnt(0)":::"memory"); \
      _Pragma("unroll") for(int d_=0;d_<4;++d_) _Pragma("unroll") for(int r=0;r<16;++r)o[d_][r]*=wsf[crow(r,hi)]; } }while(0)
  f32x16 pA0,pA1,pB0,pB1;
  int sl_prev=0,sl_cur=0,sl_next=SLOTB;
  #define ROT() do{sl_prev=sl_cur;sl_cur=sl_next;sl_next=(sl_next==(NSLOT-1)*SLOTB)?0:sl_next+SLOTB;}while(0)
  DMA_K(2,2*SLOTB);
  WAIT_BAR(4);
  qkt(pA0,pA1,Kbase,qr,r32,hi);asm volatile("s_nop 15\n\ts_nop 7":"+v"(pA0),"+v"(pA1));CMASK(pA0,pA1,0);
  START(pA0,pA1);
  _Pragma("unroll") for(int r=0;r<16;++r)pA1[r]=__builtin_amdgcn_exp2f(fsub_s(pA1[r],mhat));
  WAIT_BAR(0);
  DMA_K(3,0);DMA_V(1,SLOTB);
  ROT();
  kload8(kf,kp0+sl_cur);
  WAIT_BAR(3);
  s16x4 vlo[6],vhi[6]; u32x4 pw0,pw1,pw2,pw3;
  #define PKW(P,B) cvtpk_s(P[B],P[B+1])
  #define PAF(k) __builtin_bit_cast(bf16x8,pw##k)
  #define VFR(i) (bf16x8){vlo[i][0],vlo[i][1],vlo[i][2],vlo[i][3],vhi[i][0],vhi[i][1],vhi[i][2],vhi[i][3]}
  #define PIN(x) asm volatile("":"+v"(x))
  #define MX3(a,b,c) __builtin_fmaxf(__builtin_fmaxf((a),(b)),(c))
  #define GAPA(MF,A0,A1,A2,A3,W0,W1,PW) do{ MF; sacc+=A0; sacc+=A1; sacc+=A2; sacc+=A3; PIN(sacc); W0; W1; PIN(PW); SBAR(); }while(0)
  #define EX(v) __builtin_amdgcn_exp2f((v)-mhat)
  #define GAPB(MF,X,B) do{ MF; X[B]=EX(X[B]); X[B+1]=EX(X[B+1]); PIN(X); SBAR(); }while(0)
  #define VRD(w,db,ks) do{ vlo[w]=vtr(vp_+((db)*4096+(ks)*1024)); vhi[w]=vtr(vp_+((db)*4096+(ks)*1024+512)); }while(0)
  #define VRD2(G,w,db,ks) do{ if(G){ VRD(w,db,ks); SBAR(); } }while(0)
  #define KRD(G,j) do{ if(G){ kload2(kf,kp0+sl_next,j); SBAR(); } }while(0)
  #define STEP(C0,C1,P0,P1,t,GK,GV,GL) do{ SBAR(); \
    const lds_cptr vp_=vp0+2*sl_prev; \
    VRD(0,0,0); SBAR(); float sacc=(P0[0]+P0[1]); \
    GAPA(C0=__builtin_amdgcn_mfma_f32_32x32x16_bf16(kf[0],qr[0],zz,0,0,0), P0[2],P0[3],P0[4],P0[5],     pw0[0]=PKW(P0,0), pw0[1]=PKW(P0,2), pw0); \
    VRD(1,1,0); SBAR(); GAPA(C1=__builtin_amdgcn_mfma_f32_32x32x16_bf16(kf[1],qr[0],zz,0,0,0), P0[6],P0[7],P0[8],P0[9],     pw0[2]=PKW(P0,4), pw0[3]=PKW(P0,6), pw0); \
    VRD(2,2,0); SBAR(); GAPA(C0=__builtin_amdgcn_mfma_f32_32x32x16_bf16(kf[2],qr[1],C0,0,0,0),   P0[10],P0[11],P0[12],P0[13], pw1[0]=PKW(P0,8), pw1[1]=PKW(P0,10), pw1); \
    VRD(3,3,0); SBAR(); GAPA(C1=__builtin_amdgcn_mfma_f32_32x32x16_bf16(kf[3],qr[1],C1,0,0,0),   P0[14],P0[15],P1[0],P1[1],   pw1[2]=PKW(P0,12),pw1[3]=PKW(P0,14), pw1); \
    VRD(4,0,1); SBAR(); GAPA(C0=__builtin_amdgcn_mfma_f32_32x32x16_bf16(kf[4],qr[2],C0,0,0,0),   P1[2],P1[3],P1[4],P1[5],     pw2[0]=PKW(P1,0), pw2[1]=PKW(P1,2), pw2); \
    VRD(5,1,1); SBAR(); GAPA(C1=__builtin_amdgcn_mfma_f32_32x32x16_bf16(kf[5],qr[2],C1,0,0,0),   P1[6],P1[7],P1[8],P1[9],     pw2[2]=PKW(P1,4), pw2[3]=PKW(P1,6), pw2); \
    GAPA(C0=__builtin_amdgcn_mfma_f32_32x32x16_bf16(kf[6],qr[3],C0,0,0,0),   P1[10],P1[11],P1[12],P1[13], pw3[0]=PKW(P1,8), pw3[1]=PKW(P1,10), pw3); \
    GAPA(C1=__builtin_amdgcn_mfma_f32_32x32x16_bf16(kf[7],qr[3],C1,0,0,0),   P1[14],P1[15],0.f,0.f,       pw3[2]=PKW(P1,12),pw3[3]=PKW(P1,14), pw3); \
    l_reg+=sacc; \
    if(GK){DMA_K((t)+3,sl_cur);} if(GV){DMA_V((t)+1,sl_next);} \
    CMASK(C0,C1,t); \
    { float a=MX3(C0[0],C0[1],C1[0]),b=MX3(C0[2],C0[3],C1[1]); a=MX3(a,C1[2],C1[3]); \
      _Pragma("unroll") for(int r=4;r<16;r+=4){a=MX3(a,C0[r],C0[r+1]);b=MX3(b,C0[r+2],C0[r+3]);a=MX3(a,C1[r],C1[r+1]);b=MX3(b,C1[r+2],C1[r+3]);} \
      float rm=__builtin_fmaxf(a,b); { auto rr=__builtin_amdgcn_permlane32_swap(__float_as_uint(rm),__float_as_uint(rm),false,false); rm=__builtin_fmaxf(__uint_as_float(rr[0]),__uint_as_float(rr[1])); } \
      resc=false; rm-=mhat; \
      if(__builtin_expect(__any(rm>(float)THRL),0)){ const float dl=__builtin_fmaxf(rm,0.f); mhat+=dl; \
        const float f=__builtin_amdgcn_exp2f(-dl); l_reg*=f; if(hi==0)wsf[r32]=f; resc=true; } } \
    SBAR(); \
    GAPB(o[0]=__builtin_amdgcn_mfma_f32_32x32x16_bf16(PAF(0),VFR(0),o[0],0,0,0), C0,0); VRD2(true,0,2,1); \
    GAPB(o[1]=__builtin_amdgcn_mfma_f32_32x32x16_bf16(PAF(0),VFR(1),o[1],0,0,0), C0,2); VRD2(true,1,3,1); \
    GAPB(o[2]=__builtin_amdgcn_mfma_f32_32x32x16_bf16(PAF(0),VFR(2),o[2],0,0,0), C0,4); VRD2(true,2,0,2); \
    GAPB(o[3]=__builtin_amdgcn_mfma_f32_32x32x16_bf16(PAF(0),VFR(3),o[3],0,0,0), C0,6); VRD2(true,3,1,2); \
    GAPB(o[0]=__builtin_amdgcn_mfma_f32_32x32x16_bf16(PAF(1),VFR(4),o[0],0,0,0), C0,8); VRD2(true,4,2,2); \
    GAPB(o[1]=__builtin_amdgcn_mfma_f32_32x32x16_bf16(PAF(1),VFR(5),o[1],0,0,0), C0,10); VRD2(true,5,3,2); \
    GAPB(o[2]=__builtin_amdgcn_mfma_f32_32x32x16_bf16(PAF(1),VFR(0),o[2],0,0,0), C0,12); VRD2(true,0,0,3); \
    GAPB(o[3]=__builtin_amdgcn_mfma_f32_32x32x16_bf16(PAF(1),VFR(1),o[3],0,0,0), C0,14); VRD2(true,1,1,3); \
    GAPB(o[0]=__builtin_amdgcn_mfma_f32_32x32x16_bf16(PAF(2),VFR(2),o[0],0,0,0), C1,0); VRD2(true,2,2,3); \
    GAPB(o[1]=__builtin_amdgcn_mfma_f32_32x32x16_bf16(PAF(2),VFR(3),o[1],0,0,0), C1,2); VRD2(true,3,3,3); \
    KRD(GL,0); GAPB(o[2]=__builtin_amdgcn_mfma_f32_32x32x16_bf16(PAF(2),VFR(4),o[2],0,0,0), C1,4); \
    KRD(GL,1); GAPB(o[3]=__builtin_amdgcn_mfma_f32_32x32x16_bf16(PAF(2),VFR(5),o[3],0,0,0), C1,6); \
    KRD(GL,2); GAPB(o[0]=__builtin_amdgcn_mfma_f32_32x32x16_bf16(PAF(3),VFR(0),o[0],0,0,0), C1,8); \
    KRD(GL,3); GAPB(o[1]=__builtin_amdgcn_mfma_f32_32x32x16_bf16(PAF(3),VFR(1),o[1],0,0,0), C1,10); \
    GAPB(o[2]=__builtin_amdgcn_mfma_f32_32x32x16_bf16(PAF(3),VFR(2),o[2],0,0,0), C1,12); \
    GAPB(o[3]=__builtin_amdgcn_mfma_f32_32x32x16_bf16(PAF(3),VFR(3),o[3],0,0,0), C1,14); \
    }while(0)
  if(wid>=4)__builtin_amdgcn_s_setprio(1);
  int t=1;
  #undef CMASK
  #define CMASK(P0,P1,t) do{}while(0)
  for(;t+5<NT;t+=2){
    STEP(pB0,pB1,pA0,pA1,t,true,true,true);     WAIT_BAR(3); RESC(); ROT();
    STEP(pA0,pA1,pB0,pB1,t+1,true,true,true);   WAIT_BAR(3); RESC(); ROT();
  }
  #undef CMASK
  #define CMASK(P0,P1,t) do{int jb_=(t)-(NT-4); if(jb_>=0)cmask(P0,P1,jb_,qrel,hi);}while(0)
  #define ENDW(tt) do{ if((tt)+3<NT){WAIT_BAR(3);} else if((tt)+2<NT){WAIT_BAR(2);} else {WAIT_BAR(0);} }while(0)
  for(;t+1<NT;t+=2){
    STEP(pB0,pB1,pA0,pA1,t,(t+3<NT),(t+1<NT),(t+1<NT));       ENDW(t);   RESC(); ROT();
    STEP(pA0,pA1,pB0,pB1,t+1,(t+4<NT),(t+2<NT),(t+2<NT));     ENDW(t+1); RESC(); ROT();
  }
  STEP(pB0,pB1,pA0,pA1,NT-1,false,false,false); RESC();
  { float sacc=pB0[0]+pB0[1]; _Pragma("unroll") for(int r=2;r<16;++r)sacc+=pB0[r]; _Pragma("unroll") for(int r=0;r<16;++r)sacc+=pB1[r]; l_reg+=sacc;
    pw0=(u32x4){PKW(pB0,0),PKW(pB0,2),PKW(pB0,4),PKW(pB0,6)};pw1=(u32x4){PKW(pB0,8),PKW(pB0,10),PKW(pB0,12),PKW(pB0,14)};pw2=(u32x4){PKW(pB1,0),PKW(pB1,2),PKW(pB1,4),PKW(pB1,6)};pw3=(u32x4){PKW(pB1,8),PKW(pB1,10),PKW(pB1,12),PKW(pB1,14)};
    SBAR(); pv(o,vb0+2*sl_cur,PAF(0),PAF(1),PAF(2),PAF(3)); }
  #undef PKW
  #undef PAF
  #undef VFR
  #undef PIN
  #undef MX3
  #undef GAPA
  #undef GAPB
  #undef EX
  #undef VRD
  #undef KRD
  #undef VRD2
  #undef STEP
  #undef ENDW
  {auto rr=__builtin_amdgcn_permlane32_swap(__float_as_uint(l_reg),__float_as_uint(l_reg),false,false);l_reg=__uint_as_float(rr[0])+__uint_as_float(rr[1]);}
  if(hi==0)wsf[32+r32]=l_reg;asm volatile("s_waitcnt lgkmcnt(0)":::"memory");
  float rli[16];
  #pragma unroll
  for(int r=0;r<16;++r)rli[r]=__builtin_amdgcn_rcpf(wsf[32+crow(r,hi)]);
  bf16*Ow=O+(rowbase+q0+wid*QBLK)*OP+oc;
  { bf16*stg=(bf16*)(shm+LDS_OST)+wid*2048;
    #pragma unroll
    for(int dh=0;dh<2;++dh){
      #pragma unroll
      for(int r=0;r<16;++r){const int orow=crow(r,hi);
        #pragma unroll
        for(int d0=0;d0<2;++d0)stg[orow*64+d0*32+r32]=__float2bfloat16(o[2*dh+d0][r]*rli[r]);}
      asm volatile("s_waitcnt lgkmcnt(0)":::"memory");
      #pragma unroll
      for(int i=0;i<4;++i){const int row=i*8+(lane>>3),ch=lane&7; const u32x4 v=*(const u32x4*)(stg+row*64+ch*8); ATTN_STORE16(Ow+(long)row*OP+dh*64+ch*8,v);}
      asm volatile("s_waitcnt lgkmcnt(0)":::"memory"); } }
  __builtin_amdgcn_s_setprio(0);
  asm volatile("s_waitcnt lgkmcnt(0)\n\ts_barrier":::"memory");
  #undef DMA_K
  #undef DMA_V
  #undef CMASK
  #undef START
  #undef RESC
  #undef ROT
}
constexpr int ATTN_LDS_BYTES=LDS_BYTES;
struct AttnTensors { const bf16* Q; const bf16* K; const bf16* V; bf16* O; };
struct AttnUnit { int b, hm, qb; };
struct SlotOrder {
  int vcu, G;
  __device__ __forceinline__ SlotOrder(int grid,int block):vcu((grid%8==0)?(block%8)*(grid/8)+block/8:block),G(grid){}
  __device__ __forceinline__ bool next(int i,AttnUnit&u)const{ const int sl=vcu+(i>>2)*G; if(sl>=256)return false; const int s=sl&7,combo=sl>>3,k=i&3;
    u.b=combo>>3; u.hm=combo&7; u.qb=(k==0)?s:(k==1)?15-s:(k==2)?16+s:31-s; return true; }
};
template<class Sched,class Hook,int THRL=8> __device__ __forceinline__ void attn_phase(char*lds,const AttnTensors&T,const Sched&S,const Hook&H,const int wid){
  AttnUnit u; int i=0;
  for(;S.next(i,u);++i){ const int h=u.hm>>1,m=u.hm&1; attn_unit<THRL>(u.b,u.hm*64,u.hm*64,h*128,m*512+h*128,u.qb,T.Q,T.K,T.V,T.O,lds,wid);
    if(i<4){ H(i); asm volatile("s_waitcnt lgkmcnt(0)\n\ts_barrier":::"memory"); } }
  for(;i<4;++i){ H(i); asm volatile("s_waitcnt lgkmcnt(0)\n\ts_barrier":::"memory"); }
}
}
__device__ __forceinline__ int lane_opaque() { int l = (int)__builtin_amdgcn_mbcnt_hi(~0u, __builtin_amdgcn_mbcnt_lo(~0u, 0u)); asm volatile("" : "+v"(l)); return l; }
struct Args { const float* in[24]; float* out; unsigned char* ws; double invf[32]; };
typedef const __attribute__((address_space(4))) Args* KArgsP;
__device__ __forceinline__ KArgsP kargs() { unsigned long long p = (unsigned long long)__builtin_amdgcn_kernarg_segment_ptr(); asm volatile("" : "+s"(p)); return (KArgsP)p; }
struct ExpertCvt {
    int gw, NGW, wid; LAS unsigned char* L;
    __device__ __forceinline__ void operator()(int c) const {
        KArgsP KA = kargs(); const float* w_eg = KA->in[19]; const float* w_eu = KA->in[20]; const float* w_ed = KA->in[21];
        bf16* WguT = (bf16*)(KA->ws + WS_WGU); bf16* WdT = (bf16*)(KA->ws + WS_WD);
        constexpr int I_EG = NE * (D / 64) * (FF / 32), I_ED = NE * (FF / 64) * (D / 32), NIT = 2 * I_EG + I_ED;
        int lane_ = (int)__builtin_amdgcn_mbcnt_hi(~0u, __builtin_amdgcn_mbcnt_lo(~0u, 0u)); asm volatile("" : "+v"(lane_)); const int lane = lane_;
        const int kmax = (NIT + NGW - 1) / NGW, kc = (kmax + 3) / 4, kend = (c + 1) * kc < kmax ? (c + 1) * kc : kmax;
#define XC_ITEM(r_, W_, N_, K_, WT_, k0_, n0_, d0_) do { int xr = (r_); \
            if (xr < 2 * I_EG) { const int up = xr >= I_EG; if (up) xr -= I_EG; const int per = (D / 64) * (FF / 32), e = xr / per, q = xr % per, nblk = FF / 32, kb = q / nblk, nb = q % nblk; \
                W_ = (up ? w_eu : w_eg) + (size_t)e * D * FF; N_ = FF; K_ = D; WT_ = WguT; k0_ = 64 * kb; n0_ = 32 * nb; d0_ = e * 1024 + (n0_ >> 7) * 256 + up * 128 + (n0_ & 127); } \
            else { xr -= 2 * I_EG; const int per = (FF / 64) * (D / 32), e = xr / per, q = xr % per, nblk = D / 32, kb = q / nblk, nb = q % nblk; \
                W_ = w_ed + (size_t)e * FF * D; N_ = D; K_ = FF; WT_ = WdT; k0_ = 64 * kb; n0_ = 32 * nb; d0_ = e * 1024 + 32 * nb; } } while (0)
        for (int kb0 = c * kc; kb0 < kend; kb0 += 3) {
            float tv[3][32];
#pragma unroll
            for (int j = 0; j < 3; ++j) { const int r = gw + (kb0 + j) * NGW;
                if (kb0 + j < kend && r < NIT) { const float* W; int N, K, k0, n0, d0; bf16* WT; XC_ITEM(r, W, N, K, WT, k0, n0, d0); (void)K; (void)WT; (void)d0; transpose_load_nl(W, N, k0, n0, lane, tv[j]); } }
#pragma unroll
            for (int j = 0; j < 3; ++j) { const int r = gw + (kb0 + j) * NGW;
                if (kb0 + j < kend && r < NIT) { const float* W; int N, K, k0, n0, d0; bf16* WT; XC_ITEM(r, W, N, K, WT, k0, n0, d0); (void)W; (void)N; (void)n0; transpose_store_nl(tv[j], K, WT, k0, d0, lane); } }
        }
#undef XC_ITEM
    }
};

__global__ void __launch_bounds__(NWAVES * 64, 2) fwd(Args) {
    extern __shared__ __attribute__((aligned(16))) unsigned char lds[];
    LAS unsigned char* L = (LAS unsigned char*)lds;
    KArgsP KA = kargs();
    volatile LAS unsigned* MISC = (volatile LAS unsigned*)(L + MISC_OFF);
    const int tid = threadIdx.x, wave0 = __builtin_amdgcn_readfirstlane(tid >> 6);
    const int G0 = gridDim.x;
    const int vcu0 = (G0 % 8 == 0) ? ((int)blockIdx.x % 8) * (G0 / 8) + (int)blockIdx.x / 8 : (int)blockIdx.x;
    for (int u = tid; u < (LDS_BYTES - LDSCTL_OFF) / 4; u += NWAVES * 64) ((LAS unsigned*)(L + LDSCTL_OFF))[u] = 0u;
    __syncthreads();
    XcdBarrier bar = xcd_barrier_post((unsigned*)((gu32*)(KA->ws + WS_CTL) + CW_BAR), MISC + 8);
#define GRID_BAR() xcd_barrier(bar)

#define XIN ((const float*)KA->in[0])
#define positions ((const int*)KA->in[1])
#define w_in (KA->in[2])
#define b_gate (KA->in[3])
#define lq1 (KA->in[4])
#define lk1 (KA->in[5])
#define lq2 (KA->in[6])
#define lk2 (KA->in[7])
#define subln_g (KA->in[8])
#define w_o_att (KA->in[9])
#define conv_w (KA->in[10])
#define w_o_conv (KA->in[11])
#define w_mix (KA->in[12])
#define ln1_g (KA->in[13])
#define ln1_b (KA->in[14])
#define w_rg (KA->in[15])
#define b_rg (KA->in[16])
#define w_re (KA->in[17])
#define b_re (KA->in[18])
#define w_eg (KA->in[19])
#define w_eu (KA->in[20])
#define w_ed (KA->in[21])
#define ln2_g (KA->in[22])
#define ln2_b (KA->in[23])
#define out (KA->out)
#define ROPE ((float2*)(KA->ws + WS_ROPE))
#define LIST ((int2*)(KA->ws + WS_LIST))
#define WRT ((float*)(KA->ws + WS_WRT))
#define WinT ((bf16*)(KA->ws + WS_WIN))
#define WcatT ((bf16*)(KA->ws + WS_WOA))
#define WmixT ((bf16*)(KA->ws + WS_WMIX))
#define WguT ((bf16*)(KA->ws + WS_WGU))
#define WdT ((bf16*)(KA->ws + WS_WD))
#define XB ((bf16*)(KA->ws + WS_XB))
#define OR ((bf16*)out)
#define YS ((bf16*)(KA->ws + WS_YS))
#define QB ((bf16*)(KA->ws + WS_Q))
#define KB ((bf16*)(KA->ws + WS_K))
#define VB ((bf16*)(KA->ws + WS_V))
#define MG ((bf16*)(KA->ws + WS_MG))
#define H1B ((bf16*)(KA->ws + WS_H1B))
#define CB ((bf16*)(KA->ws + WS_CB))
#define UB ((bf16*)(KA->ws + WS_U))
#define OBF ((bf16*)out + (size_t)T * 1024)
#define HM ((bf16*)(KA->ws + WS_HM))
#define GB ((bf16*)(KA->ws + WS_G))
#define CNT ((gu32*)(KA->ws + WS_CTL) + CW_CNT)
#define RDY ((unsigned*)(KA->ws + WS_CTL) + CW_RDY)

    KA = kargs();
    { int wave = wave0, G = G0, vcu = vcu0, bidx = (int)blockIdx.x; asm volatile("" : "+s"(wave), "+s"(G), "+s"(vcu), "+s"(bidx));
      const int gw = vcu * NWAVES + wave, NGW = G * NWAVES, NGT = NGW * 64; (void)gw; (void)NGW; (void)NGT; (void)bidx;
    {
        const int lane = lane_opaque(), gt = gw * 64 + lane; (void)gt;
        LAS float* scr = (LAS float*)(L + RING_OFF + wave * 16384);
        constexpr int I_IN = (D / 64) * (NPROJ / 32), I_OA = (512 / 64) * (D / 32), I_MIX = (D / 64) * (D / 32);
        constexpr int I_EG = NE * (D / 64) * (FF / 32), I_ED = NE * (FF / 64) * (D / 32);
        constexpr int NITEMS = I_IN + 2 * I_OA + I_MIX;
        for (int it = gw; it < NITEMS; it += NGW) {
            int r = it;
            if (r < I_IN) { const int nblk = NPROJ / 32, kb = r / nblk, nb = r % nblk; transpose_item(w_in, D, NPROJ, WinT, 64 * kb, 32 * nb, n_of(32 * nb), scr, lane); continue; } r -= I_IN;
            if (r < I_OA) { const int nblk = D / 32, kb = r / nblk, nb = r % nblk; transpose_item(w_o_att, 512, D, WcatT + 512, 64 * kb, 32 * nb, 32 * nb, scr, lane, 1024); continue; } r -= I_OA;
            if (r < I_OA) { const int nblk = D / 32, kb = r / nblk, nb = r % nblk; transpose_item(w_o_conv, 512, D, WcatT, 64 * kb, 32 * nb, 32 * nb, scr, lane, 1024); continue; } r -= I_OA;
            { const int nblk = D / 32, kb = r / nblk, nb = r % nblk; transpose_item(w_mix, D, D, WmixT, 64 * kb, 32 * nb, 32 * nb, scr, lane); }
        }
        for (size_t i = (size_t)gt; i < (size_t)T * D / 4; i += (size_t)NGT * 4) { f32x4 v[4];
#pragma unroll
            for (int q = 0; q < 4; ++q) v[q] = (i + (size_t)q * NGT < (size_t)T * D / 4) ? ((const f32x4*)XIN)[i + (size_t)q * NGT] : (f32x4){0.f, 0.f, 0.f, 0.f};
#pragma unroll
            for (int q = 0; q < 4; ++q) if (i + (size_t)q * NGT < (size_t)T * D / 4) { v2u o; o.x = pk2(v[q].x, v[q].y); o.y = pk2(v[q].z, v[q].w); ((v2u*)XB)[i + (size_t)q * NGT] = o; } }
        for (int i = gt; i < T * 32; i += NGT) { const int t = i >> 5, f = i & 31; const double ang = (double)positions[t] * KA->invf[f];
            const double k = rint(ang * 0.15915494309189535); double r = fma(-k, 6.283185307179586, ang); r = fma(-k, 2.4492935982947064e-16, r);
            const float rf = (float)r; ROPE[i] = make_float2(cosf(rf), sinf(rf)); }
        for (int i = gt; i < 36 * D; i += NGT) { const int c = i >> 10, k = i & (D - 1); WRT[i] = c < 32 ? w_re[(size_t)k * 32 + c] : w_rg[(size_t)k * 4 + (c - 32)]; }
    }
    GRID_BAR();

    }
    KA = kargs();
    { int wave = wave0, G = G0, vcu = vcu0, bidx = (int)blockIdx.x; asm volatile("" : "+s"(wave), "+s"(G), "+s"(vcu), "+s"(bidx));
      const int gw = vcu * NWAVES + wave, NGW = G * NWAVES, NGT = NGW * 64; (void)gw; (void)NGW; (void)NGT; (void)bidx;
    {
        pg8::Gemm g{XB, WinT, T, NPROJ, D}; pg8::StaticOrder S; S.init(T, NPROJ, G, bidx);
        pg8::EpiProj E{QB, KB, VB, CB, UB, GB, (const float*)ROPE, b_gate, C2};
        pg8::gemm_phase<pg8::EpiProj, pg8::StaticOrder, true, true>(L + RING_OFF, g, S, E, wave);
    }
    GRID_BAR();

    }
    KA = kargs();
    { int wave = wave0, G = G0, vcu = vcu0, bidx = (int)blockIdx.x; asm volatile("" : "+s"(wave), "+s"(G), "+s"(vcu), "+s"(bidx));
      const int gw = vcu * NWAVES + wave, NGW = G * NWAVES, NGT = NGW * 64; (void)gw; (void)NGW; (void)NGT; (void)bidx;
    { const int lane = lane_opaque(), gt = gw * 64 + lane;
    for (int i = gt; i < T * 64; i += NGT) { const int t = i >> 6, c0 = (i & 63) * 8, s = t & (SEQ - 1);
        const v4u cb = *(const v4u*)(CB + (size_t)t * 512 + c0), u2 = *(const v4u*)(UB + (size_t)t * 512 + c0);
        v4u u1 = {0u, 0u, 0u, 0u}, u0 = {0u, 0u, 0u, 0u};
        if (s >= 1) u1 = *(const v4u*)(UB + (size_t)(t - 1) * 512 + c0);
        if (s >= 2) u0 = *(const v4u*)(UB + (size_t)(t - 2) * 512 + c0);
        v4u o;
#pragma unroll
        for (int j = 0; j < 4; ++j) { const int c = c0 + 2 * j;
            const float ylo = conv_w[c] * bflo(u0[j]) + conv_w[512 + c] * bflo(u1[j]) + conv_w[1024 + c] * bflo(u2[j]);
            const float yhi = conv_w[c + 1] * bfhi(u0[j]) + conv_w[512 + c + 1] * bfhi(u1[j]) + conv_w[1024 + c + 1] * bfhi(u2[j]);
            o[j] = pk2(bflo(cb[j]) * ylo, bfhi(cb[j]) * yhi); }
        *(v4u*)(OBF + (size_t)t * 1024 + c0) = o; } }

    }
    KA = kargs();
    { int wave = wave0, G = G0, vcu = vcu0, bidx = (int)blockIdx.x; asm volatile("" : "+s"(wave), "+s"(G), "+s"(vcu), "+s"(bidx));
      const int gw = vcu * NWAVES + wave, NGW = G * NWAVES, NGT = NGW * 64; (void)gw; (void)NGW; (void)NGT; (void)bidx;
    {
        const attn_b::AttnTensors AT{(const attn_b::bf16*)QB, (const attn_b::bf16*)KB, (const attn_b::bf16*)VB, (attn_b::bf16*)OR};
        const attn_b::SlotOrder S(G, bidx);
        const ExpertCvt H{gw, NGW, wave, L};
        attn_b::attn_phase<attn_b::SlotOrder, ExpertCvt>((char*)lds + RING_OFF, AT, S, H, wave);
    }
    GRID_BAR();

    }
    KA = kargs();
    { int wave = wave0, G = G0, vcu = vcu0, bidx = (int)blockIdx.x; asm volatile("" : "+s"(wave), "+s"(G), "+s"(vcu), "+s"(bidx));
      const int gw = vcu * NWAVES + wave, NGW = G * NWAVES, NGT = NGW * 64; (void)gw; (void)NGW; (void)NGT; (void)bidx;
    {
        const int lane = lane_opaque(), gt = gw * 64 + lane; (void)gt;
        float lam;
        { const float p1 = lq1[lane] * lk1[lane], p2 = lq2[lane] * lk2[lane]; lam = expf(wave_sum(p1)) - expf(wave_sum(p2)) + LAMBDA_INIT; }
        float sg[8];
#pragma unroll
        for (int e = 0; e < 8; ++e) sg[e] = subln_g[(lane & 15) * 8 + e] * (1.f - LAMBDA_INIT);
        for (int t0 = gw * 4; t0 < T; t0 += NGW * 4) {
            v4u a[4], bb[4];
#pragma unroll
            for (int r = 0; r < 4; ++r) { a[r] = *(const v4u*)(OR + (size_t)(t0 + r) * 1024 + lane * 8); bb[r] = *(const v4u*)(OR + (size_t)(t0 + r) * 1024 + 512 + lane * 8); }
#pragma unroll
            for (int r = 0; r < 4; ++r) { float v[8]; float ss = 0.f;
#pragma unroll
                for (int e = 0; e < 4; ++e) { v[2 * e] = bflo(a[r][e]) - lam * bflo(bb[r][e]); v[2 * e + 1] = bfhi(a[r][e]) - lam * bfhi(bb[r][e]); ss += v[2 * e] * v[2 * e] + v[2 * e + 1] * v[2 * e + 1]; }
                ss += __shfl_xor(ss, 1); ss += __shfl_xor(ss, 2); ss += __shfl_xor(ss, 4); ss += __shfl_xor(ss, 8);
                const float rs = 1.f / sqrtf(ss * (1.f / 128.f) + SUBLN_EPS); v4u o;
#pragma unroll
                for (int e = 0; e < 4; ++e) o[e] = pk2(v[2 * e] * rs * sg[2 * e], v[2 * e + 1] * rs * sg[2 * e + 1]);
                *(v4u*)(OBF + (size_t)(t0 + r) * 1024 + 512 + lane * 8) = o; }
        }
    }
    GRID_BAR();

    }
    KA = kargs();
    { int wave = wave0, G = G0, vcu = vcu0, bidx = (int)blockIdx.x; asm volatile("" : "+s"(wave), "+s"(G), "+s"(vcu), "+s"(bidx));
      const int gw = vcu * NWAVES + wave, NGW = G * NWAVES, NGT = NGW * 64; (void)gw; (void)NGW; (void)NGT; (void)bidx;
    {
        pg8::PlainSrc S; S.init(T, 1024, G, bidx);
        { pg8::Gemm g{OBF, WcatT, T, 1024, D}; pg8::EpiMerge E{MG, GB}; pg8::gemm_phase2<pg8::EpiMerge, pg8::PlainSrc>(L + RING_OFF, g, S, E, wave); }
    }
    GRID_BAR();

    }
    KA = kargs();
    { int wave = wave0, G = G0, vcu = vcu0, bidx = (int)blockIdx.x; asm volatile("" : "+s"(wave), "+s"(G), "+s"(vcu), "+s"(bidx));
      const int gw = vcu * NWAVES + wave, NGW = G * NWAVES, NGT = NGW * 64; (void)gw; (void)NGW; (void)NGT; (void)bidx;
    {
        pg8::PlainSrc S; S.init(T, 1024, G, bidx);
        pg8::Gemm g{MG, WmixT, T, 1024, D}; pg8::EpiResB E{XB, ALPHA}; pg8::gemm_phase2<pg8::EpiResB, pg8::PlainSrc>(L + RING_OFF, g, S, E, wave);
    }
    GRID_BAR();

    }
    KA = kargs();
    { int wave = wave0, G = G0, vcu = vcu0, bidx = (int)blockIdx.x; asm volatile("" : "+s"(wave), "+s"(G), "+s"(vcu), "+s"(bidx));
      const int gw = vcu * NWAVES + wave, NGW = G * NWAVES, NGT = NGW * 64; (void)gw; (void)NGW; (void)NGT; (void)bidx;
    {
        const int lane = lane_opaque(), tid7 = wave * 64 + lane;
        LAS float* HR = (LAS float*)(L + RING_OFF);
        LAS float* LG = (LAS float*)(L + LDSCTL_OFF + 2048);
        LAS int* CL = (LAS int*)(L + LDSCTL_OFF + 2048 + 4736);
        LAS int* RES = CL + 64;
        for (int blk = vcu; blk < T / 128; blk += G) {
            const int row0 = blk * 128;
            if (tid7 < 32) CL[tid7] = 0;
            f32x4 wE[16], wG[16];
            { const float* wep = WRT + (size_t)(lane & 31) * D + wave * 128 + 4 * (lane >> 5); const float* wgp = WRT + (size_t)(32 + (lane & 3)) * D + wave * 128 + 4 * (lane >> 5);
#pragma unroll
              for (int j = 0; j < 16; ++j) { wE[j] = *(const f32x4*)(wep + 8 * j); wG[j] = *(const f32x4*)(wgp + 8 * j); } }
            for (int sb = 0; sb < 4; ++sb) {
                v4u pw[4][2];
#pragma unroll
                for (int rr = 0; rr < 4; ++rr)
#pragma unroll
                    for (int j = 0; j < 2; ++j) pw[rr][j] = *(const v4u*)(XB + (size_t)(row0 + sb * 32 + wave * 4 + rr) * D + 8 * lane + 512 * j);
#pragma unroll
                for (int rr = 0; rr < 4; ++rr) { const int rl = wave * 4 + rr, t = row0 + sb * 32 + rl;
                    f32x4 v[4]; float sm = 0.f;
#pragma unroll
                    for (int j = 0; j < 2; ++j) { const v4u w = pw[rr][j];
                        v[2 * j] = (f32x4){bflo(w.x), bfhi(w.x), bflo(w.y), bfhi(w.y)}; v[2 * j + 1] = (f32x4){bflo(w.z), bfhi(w.z), bflo(w.w), bfhi(w.w)}; }
#pragma unroll
                    for (int j = 0; j < 4; ++j) sm += (v[j].x + v[j].y) + (v[j].z + v[j].w);
                    const float mean = wave_sum(sm) * (1.f / D); float s2 = 0.f;
#pragma unroll
                    for (int j = 0; j < 4; ++j) { v[j] = v[j] - mean; s2 += (v[j].x * v[j].x + v[j].y * v[j].y) + (v[j].z * v[j].z + v[j].w * v[j].w); }
                    const float rstd = 1.f / sqrtf(wave_sum(s2) * (1.f / D) + LN_EPS);
#pragma unroll
                    for (int j = 0; j < 2; ++j) { const int c0 = 8 * lane + 512 * j;
#pragma unroll
                        for (int q = 0; q < 2; ++q) { const f32x4 gg = *(const f32x4*)(ln1_g + c0 + 4 * q), bb = *(const f32x4*)(ln1_b + c0 + 4 * q);
                            v[2 * j + q] = v[2 * j + q] * rstd * gg + bb; *(LAS f32x4*)(HR + rl * 1028 + c0 + 4 * q) = v[2 * j + q]; }
                        v4u o; o.x = pk2(v[2 * j].x, v[2 * j].y); o.y = pk2(v[2 * j].z, v[2 * j].w); o.z = pk2(v[2 * j + 1].x, v[2 * j + 1].y); o.w = pk2(v[2 * j + 1].z, v[2 * j + 1].w);
                        *(v4u*)(H1B + (size_t)t * D + c0) = o; } }
                __syncthreads();
                { const int r32 = lane & 31, half = lane >> 5;
                  const LAS float* hp = HR + r32 * 1028 + wave * 128 + 4 * half;
                  f32x16 a0 = f32x16{}; f32x4 g4 = (f32x4){0.f, 0.f, 0.f, 0.f};
#pragma unroll
                  for (int j = 0; j < 16; ++j) { const f32x4 hv = *(const LAS f32x4*)(hp + 8 * j), we = wE[j], wg = wG[j];
#pragma unroll
                      for (int q = 0; q < 4; ++q) { a0 = __builtin_amdgcn_mfma_f32_32x32x2f32(hv[q], we[q], a0, 0, 0, 0); g4 = __builtin_amdgcn_mfma_f32_4x4x1f32(hv[q], wg[q], g4, 0, 0, 0); }
                      if ((j & 3) == 3) __builtin_amdgcn_sched_barrier(0); }
                  __syncthreads();
#pragma unroll
                  for (int r = 0; r < 16; ++r) HR[(wave * 32 + r) * 64 + lane] = a0[r];
#pragma unroll
                  for (int i = 0; i < 4; ++i) HR[(wave * 32 + 16 + i) * 64 + lane] = g4[i];
                  __syncthreads();
                  if (wave < 5) {
#pragma unroll
                  for (int q = 0; q < 4; ++q) { const int rg = wave * 4 + q; float sm = 0.f;
#pragma unroll
                      for (int w2 = 0; w2 < 8; ++w2) sm += HR[(w2 * 32 + rg) * 64 + lane];
                      if (rg < 16) LG[crow(rg, half) * 37 + r32] = sm;
                      else { sm += __shfl_xor(sm, 32); if (lane < 32) LG[(4 * ((lane >> 2) & 7) + (rg - 16)) * 37 + 32 + (lane & 3)] = sm; } } }
                  __syncthreads(); }
                if (tid7 < 32) {
                    float pg[4], pe[32];
#pragma unroll
                    for (int e = 0; e < 32; ++e) pe[e] = LG[tid7 * 37 + e] + b_re[e];
#pragma unroll
                    for (int e = 0; e < 4; ++e) pg[e] = LG[tid7 * 37 + 32 + e] + b_rg[e];
                    int gs = 0; float gm = pg[0];
#pragma unroll
                    for (int e = 1; e < 4; ++e) if (pg[e] > gm) { gm = pg[e]; gs = e; }
                    float den = 0.f;
#pragma unroll
                    for (int e = 0; e < 4; ++e) den += expf(pg[e] - gm);
                    const float gwt = 1.f / den;
                    float ev[8];
#pragma unroll
                    for (int i = 0; i < 8; ++i) ev[i] = gs == 0 ? pe[i] : gs == 1 ? pe[8 + i] : gs == 2 ? pe[16 + i] : pe[24 + i];
                    int i0 = 0; float v0 = ev[0];
#pragma unroll
                    for (int i = 1; i < 8; ++i) if (ev[i] > v0) { v0 = ev[i]; i0 = i; }
                    int i1 = -1; float v1 = -INFINITY;
#pragma unroll
                    for (int i = 0; i < 8; ++i) if (i != i0 && ev[i] > v1) { v1 = ev[i]; i1 = i; }
                    const float ex = expf(v1 - v0), p0 = gwt / (1.f + ex), p1 = gwt * ex / (1.f + ex);
                    const int e0 = gs * 8 + i0, e1 = gs * 8 + i1;
                    const int lr0 = atomicAdd((int*)&CL[e0], 1), lr1 = atomicAdd((int*)&CL[e1], 1);
                    LAS int* rs = RES + (sb * 32 + tid7) * 6; rs[0] = e0; rs[1] = e1; rs[2] = lr0; rs[3] = lr1; rs[4] = __float_as_int(p0); rs[5] = __float_as_int(p1);
                }
            }
            __syncthreads();
            if (tid7 < 32) { const int c = CL[tid7]; CL[32 + tid7] = c ? (int)__hip_atomic_fetch_add(CNT + tid7, (unsigned)c, RLX_AGENT) : 0; }
            __syncthreads();
            if (tid7 < 128) { const int t = row0 + tid7; const LAS int* rs = RES + tid7 * 6; const int e0 = rs[0], e1 = rs[1];
                LIST[e0 * LISTCAP + CL[32 + e0] + rs[2]] = make_int2(2 * t, rs[4]); LIST[e1 * LISTCAP + CL[32 + e1] + rs[3]] = make_int2(2 * t + 1, rs[5]); }
            __syncthreads();
        }
    }
    GRID_BAR();
    }
    KA = kargs();
    { int wave = wave0, G = G0, vcu = vcu0, bidx = (int)blockIdx.x; asm volatile("" : "+s"(wave), "+s"(G), "+s"(vcu), "+s"(bidx));
      const int gw = vcu * NWAVES + wave, NGW = G * NWAVES, NGT = NGW * 64; (void)gw; (void)NGW; (void)NGT; (void)bidx;
    {
        { pg8::MoeSrc<0> S; S.init((const unsigned*)CNT, (LAS int*)(L + LDSCTL_OFF + 1024), G, vcu, 4, LIST, RDY, wave);
          pg8::Gemm g{H1B, WguT, 0, 0, D}; pg8::EpiSwiglu E{HM}; pg8::gemm_phase2<pg8::EpiSwiglu, pg8::MoeSrc<0>>(L + RING_OFF, g, S, E, wave); }
        { pg8::MoeSrc<1> S; S.init((const unsigned*)CNT, (LAS int*)(L + LDSCTL_OFF + 1024), G, vcu, 4, LIST, RDY, wave);
          pg8::Gemm g{HM, WdT, 0, 0, FF}; pg8::EpiDown E{YS, LIST}; pg8::gemm_phase2<pg8::EpiDown, pg8::MoeSrc<1>>(L + RING_OFF, g, S, E, wave); }
    }
    GRID_BAR();

    }
    KA = kargs();
    { int wave = wave0, G = G0, vcu = vcu0, bidx = (int)blockIdx.x; asm volatile("" : "+s"(wave), "+s"(G), "+s"(vcu), "+s"(bidx));
      const int gw = vcu * NWAVES + wave, NGW = G * NWAVES, NGT = NGW * 64; (void)gw; (void)NGW; (void)NGT; (void)bidx;
    { const int lane = lane_opaque();
    for (int t0 = gw * 4; t0 < T; t0 += NGW * 4) {
        v2u hw[4][4], y0[4][4], y1[4][4];
#pragma unroll
        for (int r = 0; r < 4; ++r)
#pragma unroll
            for (int j = 0; j < 4; ++j) { const int c0 = 4 * lane + 256 * j; const size_t t = (size_t)(t0 + r);
                hw[r][j] = *(const v2u*)(H1B + t * D + c0); y0[r][j] = *(const v2u*)(YS + (2 * t) * D + c0); y1[r][j] = *(const v2u*)(YS + (2 * t + 1) * D + c0); }
#pragma unroll
        for (int r = 0; r < 4; ++r) { const size_t t = (size_t)(t0 + r);
            f32x4 v[4]; float s = 0.f;
#pragma unroll
            for (int j = 0; j < 4; ++j) {
                v[j].x = ALPHA * bflo(hw[r][j].x) + (bflo(y0[r][j].x) + bflo(y1[r][j].x)); v[j].y = ALPHA * bfhi(hw[r][j].x) + (bfhi(y0[r][j].x) + bfhi(y1[r][j].x));
                v[j].z = ALPHA * bflo(hw[r][j].y) + (bflo(y0[r][j].y) + bflo(y1[r][j].y)); v[j].w = ALPHA * bfhi(hw[r][j].y) + (bfhi(y0[r][j].y) + bfhi(y1[r][j].y));
                s += (v[j].x + v[j].y) + (v[j].z + v[j].w); }
            const float mean = wave_sum(s) * (1.f / D); float s2 = 0.f;
#pragma unroll
            for (int j = 0; j < 4; ++j) { v[j] = v[j] - mean; s2 += (v[j].x * v[j].x + v[j].y * v[j].y) + (v[j].z * v[j].z + v[j].w * v[j].w); }
            const float rstd = 1.f / sqrtf(wave_sum(s2) * (1.f / D) + LN_EPS);
#pragma unroll
            for (int j = 0; j < 4; ++j) { const int c0 = 4 * lane + 256 * j; const f32x4 gg = *(const f32x4*)(ln2_g + c0), bb = *(const f32x4*)(ln2_b + c0);
                *(f32x4*)(out + t * D + c0) = v[j] * rstd * gg + bb; } }
    } }
    }
}

#undef XIN
#undef positions
#undef w_in
#undef b_gate
#undef lq1
#undef lk1
#undef lq2
#undef lk2
#undef subln_g
#undef w_o_att
#undef conv_w
#undef w_o_conv
#undef w_mix
#undef ln1_g
#undef ln1_b
#undef w_rg
#undef b_rg
#undef w_re
#undef b_re
#undef w_eg
#undef w_eu
#undef w_ed
#undef ln2_g
#undef ln2_b
#undef out
#undef ROPE
#undef LIST
#undef WRT
#undef WinT
#undef WcatT
#undef WmixT
#undef WguT
#undef WdT
#undef XB
#undef OR
#undef YS
#undef QB
#undef KB
#undef VB
#undef MG
#undef H1B
#undef CB
#undef UB
#undef OBF
#undef HM
#undef GB
#undef CNT
#undef RDY
extern "C" void kernel_launch(void* const* d_in, const int* in_sizes, int n_in, void* d_out, int out_size, void* d_ws, size_t ws_size, hipStream_t stream) {
    static int grid = 0;
    if (grid == 0) {
        if (n_in != 24 || in_sizes[0] != T * D || out_size != T * D || ws_size < WS_END) { fprintf(stderr, "kernel_launch: unexpected shapes (n_in %d, in0 %d, out %d, ws %zu); nothing launched\n", n_in, n_in > 0 ? in_sizes[0] : -1, out_size, ws_size); grid = -1; return; }
        int dev = 0, cus = 0, per_cu = 0;
        if (hipGetDevice(&dev) != hipSuccess || hipDeviceGetAttribute(&cus, hipDeviceAttributeMultiprocessorCount, dev) != hipSuccess) { grid = -1; return; }
        if (hipFuncSetAttribute((const void*)fwd, hipFuncAttributeMaxDynamicSharedMemorySize, LDS_BYTES) != hipSuccess) { fprintf(stderr, "kernel_launch: hipFuncSetAttribute failed\n"); grid = -1; return; }
        if (hipOccupancyMaxActiveBlocksPerMultiprocessor(&per_cu, (const void*)fwd, NWAVES * 64, LDS_BYTES) != hipSuccess || per_cu < 1) { fprintf(stderr, "kernel_launch: occupancy query says %d\n", per_cu); }
        (void)hipGetLastError();
        grid = cus;
    }
    if (grid < 0) return;
    if (hipMemsetAsync((char*)d_ws + WS_CTL, 0, CTL_ZERO_BYTES, stream) != hipSuccess) return;
    Args a{};
    for (int i = 0; i < 24; ++i) a.in[i] = (const float*)d_in[i];
    a.out = (float*)d_out; a.ws = (unsigned char*)d_ws;
    for (int i = 0; i < 32; ++i) a.invf[i] = pow(10000.0, -(double)i / 32.0);
    hipLaunchKernelGGL(fwd, dim3(grid), dim3(NWAVES * 64), LDS_BYTES, stream, a);
}
```

```cpp
#include <hip/hip_runtime.h>
#include <cstdio>
#include <cstdint>
#include <cmath>

#define GAS __attribute__((address_space(1)))
#define LAS __attribute__((address_space(3)))
typedef unsigned short bf16;
typedef unsigned v4u __attribute__((ext_vector_type(4)));
typedef unsigned v2u __attribute__((ext_vector_type(2)));
typedef float f32x4 __attribute__((ext_vector_type(4)));
typedef float f32x16 __attribute__((ext_vector_type(16)));
typedef short bf16x8 __attribute__((ext_vector_type(8)));
typedef GAS unsigned gu32;
#define RLX_AGENT __ATOMIC_RELAXED, __HIP_MEMORY_SCOPE_AGENT
#define LDS_WAIT() asm volatile("s_waitcnt lgkmcnt(0)" ::: "memory")
#define VM_WAIT() asm volatile("s_waitcnt vmcnt(0)" ::: "memory")


constexpr int NWAVES = 8;
constexpr int BATCH = 4, SEQ = 8192, T = BATCH * SEQ, D = 1024, NPROJ = 5120;
constexpr int NE = 32, FF = 512, LISTCAP = 32768;
constexpr float LN_EPS = 1e-5f, SUBLN_EPS = 1e-5f;
constexpr float ALPHA = 1.189207115002721f;
constexpr float LAMBDA_INIT = 0.2f;
constexpr float C2 = 0.125f * 1.4426950408889634f;

constexpr size_t MiB = 1u << 20;
constexpr size_t WS_CTL = 0, CTL_ZERO_BYTES = 1 * MiB;
constexpr size_t WS_ROPE = 1 * MiB;
constexpr size_t WS_LIST = 1 * MiB;
constexpr size_t WS_WGT = 13 * MiB;
constexpr size_t WS_WRT = 14 * MiB;
constexpr size_t WS_WIN = 16 * MiB;
constexpr size_t WS_WOA = 26 * MiB, WS_WOC = 27 * MiB, WS_WMIX = 28 * MiB;
constexpr size_t WS_WGU = 32 * MiB;
constexpr size_t WS_WD = 96 * MiB;
constexpr size_t WS_XB = 128 * MiB;
constexpr size_t WS_OR = 128 * MiB;
constexpr size_t WS_YS = 128 * MiB;
constexpr size_t WS_Q = 192 * MiB, WS_K = 224 * MiB, WS_V = 256 * MiB;
constexpr size_t WS_MG = 288 * MiB;
constexpr size_t WS_H1B = 288 * MiB;
constexpr size_t WS_CB = 288 * MiB, WS_U = 320 * MiB;
constexpr size_t WS_OB = 288 * MiB;
constexpr size_t WS_F = 352 * MiB;
constexpr size_t WS_HM = 352 * MiB;
constexpr size_t WS_G = 384 * MiB;
constexpr size_t WS_END = 512 * MiB;
constexpr int CW_XBAD = 512;
constexpr int CW_P2DONE = 640;
constexpr int CW_WDONE = 704;
constexpr int CW_P7DONE = 768;
constexpr int CW_CNT = 1024;
constexpr int CW_RDY = 16384;
constexpr int CW_BAR = 4096;

constexpr int RING_OFF = 0, RING_BYTES = 135168;
constexpr int LDSCTL_OFF = RING_BYTES, MISC_OFF = LDSCTL_OFF + 320;
constexpr int LDS_BYTES = 151552;

__device__ __forceinline__ unsigned f2bf(float f) { unsigned u = __builtin_bit_cast(unsigned, f); return (u + 0x7fffu + ((u >> 16) & 1u)) >> 16; }
__device__ __forceinline__ unsigned pk2(float lo, float hi) { return f2bf(lo) | (f2bf(hi) << 16); }
__device__ __forceinline__ float bflo(unsigned u) { return __uint_as_float(u << 16); }
__device__ __forceinline__ float bfhi(unsigned u) { return __uint_as_float(u & 0xffff0000u); }
__device__ __forceinline__ float bf2f(bf16 h) { return __uint_as_float((unsigned)h << 16); }

__device__ __forceinline__ int lane_id() { return (int)__builtin_amdgcn_mbcnt_hi(~0u, __builtin_amdgcn_mbcnt_lo(~0u, 0u)); }
#define XB_TMO      128
#define XB_XCNT(j)  (256  + 64 * (j))
#define XB_XSUB(j)  (1280 + 64 * (j))
#define XB_XGEN(j)  (2304 + 64 * (j))
#define XB_TOP      3328
#define XB_TOPGEN   3392
#define XB_LSUB(j)  (3456 + 64 * (j))
#define XB_LGEN(j)  (3968 + 64 * (j))
#define XB_PTOP(p)  (4480 + 64 * (p))
#define XB_PGEN(p)  (4736 + 64 * (p))
#define XCD_BAR_WORDS 4992
#define XB_SPIN_CAP (1u << 26)

__device__ __forceinline__ unsigned xb_ld(unsigned* p)              { return __hip_atomic_load(p, __ATOMIC_RELAXED, __HIP_MEMORY_SCOPE_AGENT); }
__device__ __forceinline__ unsigned xb_add(unsigned* p, unsigned v) { return __hip_atomic_fetch_add(p, v, __ATOMIC_RELAXED, __HIP_MEMORY_SCOPE_AGENT); }
__device__ __forceinline__ unsigned xb_xcc_id() { return (unsigned)__builtin_amdgcn_s_getreg((3 << 11) | 20) & 0xFu; }
#define XB_SPIN(cond, bar) do { unsigned _sp = 0; while (cond) { __builtin_amdgcn_s_sleep(1); \
    if ((++_sp & 255u) == 0u) { if (xb_ld(&(bar)[XB_TMO])) break; if (_sp > XB_SPIN_CAP) { atomicAdd(&(bar)[XB_TMO], 1u); break; } } } } while (0)

struct XcdBarrier { unsigned* bar; unsigned x; volatile LAS unsigned* st; int wave; };

__device__ __forceinline__ XcdBarrier xcd_barrier_post(unsigned* bar, volatile LAS unsigned* st) {
    XcdBarrier b; b.bar = bar; b.x = xb_xcc_id(); b.st = st; b.wave = __builtin_amdgcn_readfirstlane((int)threadIdx.x >> 6);
    const unsigned bad = (b.x != (unsigned)blockIdx.x % 8u || gridDim.x != 256u) ? 65536u : 0u;
    if (threadIdx.x == 0) (void)xb_add(&bar[XB_XCNT(b.x)], 1u + bad);
    return b;
}
__device__ __forceinline__ void xcd_barrier_complete(unsigned* bar, unsigned x, unsigned& nloc, unsigned& nx, unsigned& bad) {
    const unsigned G = gridDim.x * gridDim.y * gridDim.z;
    unsigned sum, cnt, mine, sp = 0u;
    for (;;) {
        sum = 0u; cnt = 0u; mine = 0u; bad = 0u;
#pragma unroll
        for (unsigned j = 0; j < 16; ++j) { const unsigned cc = xb_ld(&bar[XB_XCNT(j)]), c = cc & 0xffffu; bad |= cc >> 16; sum += c; cnt += (c > 0u) ? 1u : 0u; mine = (j == x) ? c : mine; }
        if (sum == G) break;
        __builtin_amdgcn_s_sleep(1);
        if ((++sp & 255u) == 0u) { if (xb_ld(&bar[XB_TMO])) break; if (sp > XB_SPIN_CAP) { atomicAdd(&bar[XB_TMO], 1u); break; } }
    }
    nloc = mine > 0u ? mine : 1u; nx = cnt > 0u ? cnt : 1u;
}
template <bool RELEASE = true> __device__ __forceinline__ void xcd_barrier(const XcdBarrier& b) {
    asm volatile("s_waitcnt vmcnt(0)" ::: "memory");
    __syncthreads();
    if (b.wave == 0 && lane_id() == 0) {
        unsigned* bar = b.bar;
        __builtin_amdgcn_s_waitcnt(0);
        unsigned nloc = b.st[0], nx = b.st[1];
        if (nloc == 0u) { unsigned bad; xcd_barrier_complete(bar, b.x, nloc, nx, bad); b.st[0] = nloc; b.st[1] = nx; b.st[2] = bad; }
        const unsigned old = xb_add(&bar[XB_XSUB(b.x)], 1u);
        const unsigned gen = old / nloc;
        if (old + 1u == (gen + 1u) * nloc) {
            if constexpr (RELEASE) __builtin_amdgcn_fence(__ATOMIC_RELEASE, "agent");
            asm volatile("s_waitcnt vmcnt(0)" ::: "memory");
            const unsigned og = xb_add(&bar[XB_TOP], 1u);
            const unsigned tg = og / nx;
            if (og + 1u == (tg + 1u) * nx) xb_add(&bar[XB_TOPGEN], 1u);
            else XB_SPIN(xb_ld(&bar[XB_TOPGEN]) == tg, bar);
            __builtin_amdgcn_fence(__ATOMIC_ACQUIRE, "agent");
            xb_add(&bar[XB_XGEN(b.x)], 1u);
            asm volatile("s_waitcnt vmcnt(0)" ::: "memory");
        } else {
            XB_SPIN(xb_ld(&bar[XB_XGEN(b.x)]) == gen, bar);
            __builtin_amdgcn_fence(__ATOMIC_ACQUIRE, "agent");
            asm volatile("s_waitcnt vmcnt(0)" ::: "memory");
        }
    }
    __syncthreads();
}

__device__ __forceinline__ void xcd_barrier_pair(const XcdBarrier& b) {
    asm volatile("s_waitcnt vmcnt(0)" ::: "memory");
    __syncthreads();
    if (b.wave == 0 && lane_id() == 0) {
        unsigned* bar = b.bar;
        __builtin_amdgcn_s_waitcnt(0);
        const unsigned nloc = b.st[0];
        const unsigned old = xb_add(&bar[XB_XSUB(b.x)], 1u);
        const unsigned gen = old / nloc;
        if (old + 1u == (gen + 1u) * nloc) {
            __builtin_amdgcn_fence(__ATOMIC_RELEASE, "agent");
            asm volatile("s_waitcnt vmcnt(0)" ::: "memory");
            const unsigned p = b.x >> 1;
            const unsigned og = xb_add(&bar[XB_PTOP(p)], 1u);
            const unsigned tg = og / 2u;
            if (og + 1u == (tg + 1u) * 2u) xb_add(&bar[XB_PGEN(p)], 1u);
            else XB_SPIN(xb_ld(&bar[XB_PGEN(p)]) == tg, bar);
            __builtin_amdgcn_fence(__ATOMIC_ACQUIRE, "agent");
            xb_add(&bar[XB_XGEN(b.x)], 1u);
            asm volatile("s_waitcnt vmcnt(0)" ::: "memory");
        } else {
            XB_SPIN(xb_ld(&bar[XB_XGEN(b.x)]) == gen, bar);
            __builtin_amdgcn_fence(__ATOMIC_ACQUIRE, "agent");
            asm volatile("s_waitcnt vmcnt(0)" ::: "memory");
        }
    }
    __syncthreads();
}

template <bool RELEASE = false> __device__ __forceinline__ void xcd_barrier_local(const XcdBarrier& b) {
    asm volatile("s_waitcnt vmcnt(0)" ::: "memory");
    __syncthreads();
    if (b.wave == 0 && lane_id() == 0) {
        unsigned* bar = b.bar;
        __builtin_amdgcn_s_waitcnt(0);
        const unsigned nloc = b.st[0];
        const unsigned old = xb_add(&bar[XB_LSUB(b.x)], 1u);
        const unsigned gen = old / nloc;
        if (old + 1u == (gen + 1u) * nloc) { if constexpr (RELEASE) { __builtin_amdgcn_fence(__ATOMIC_RELEASE, "agent"); asm volatile("s_waitcnt vmcnt(0)" ::: "memory"); } xb_add(&bar[XB_LGEN(b.x)], 1u); }
        else XB_SPIN(xb_ld(&bar[XB_LGEN(b.x)]) == gen, bar);
        __builtin_amdgcn_fence(__ATOMIC_ACQUIRE, "agent");
        asm volatile("s_waitcnt vmcnt(0)" ::: "memory");
    }
    __syncthreads();
}

__host__ __device__ __forceinline__ int orig_of(int n) {
    const int tile = n >> 8, c = n & 255;
    if (tile < 4) { const int base = (tile >> 1) * 512 + (tile & 1) * 256, half = c >> 7, cc = c & 127, g = cc >> 5, i = cc & 31; return base + g * 64 + half * 32 + i; }
    if (tile >= 8 && tile < 12) { const int p = tile - 8, half = c >> 7; return 2048 + half * 512 + p * 128 + (c & 127); }
    if (tile >= 12) { const int p = tile - 12, half = c >> 7; return 3072 + half * 1024 + p * 128 + (c & 127); }
    return n;
}
__host__ __device__ __forceinline__ int n_of(int orig) {
    if (orig < 1024) { const int sec = orig >> 9, o = orig & 511, tl = o >> 8, o2 = o & 255, g = o2 >> 6, d = o2 & 63, half = d >> 5, i = d & 31; return (sec * 2 + tl) * 256 + half * 128 + g * 32 + i; }
    if (orig >= 2048 && orig < 3072) { const int o = orig - 2048, half = o >> 9, ch = o & 511, p = ch >> 7; return (8 + p) * 256 + half * 128 + (ch & 127); }
    if (orig >= 3072) { const int o = orig - 3072, half = o >> 10, ch = o & 1023, p = ch >> 7; return (12 + p) * 256 + half * 128 + (ch & 127); }
    return orig;
}

__device__ __forceinline__ float wave_sum(float v) {
#pragma unroll
    for (int o = 1; o < 64; o <<= 1) v += __shfl_xor(v, o);
    return v;
}
__device__ __forceinline__ void store16_wt(void* p, v4u v) { asm volatile("global_store_dwordx4 %0, %1, off sc1\n\ts_nop 1" :: "v"(p), "v"(v) : "memory"); }
template <bool SC1 = false> __device__ __forceinline__ void transpose_item(const float* W, int K, int N, bf16* WT, int k0, int n0, int dst_row0, LAS float* scr, int lane, int ldk = 0) {
    if (ldk == 0) ldk = K;
    f32x4 tv[8];
#pragma unroll
    for (int i = 0; i < 8; ++i) tv[i] = *(const f32x4*)(W + (size_t)(k0 + 8 * i + (lane >> 3)) * N + n0 + (lane & 7) * 4);
#pragma unroll
    for (int i = 0; i < 8; ++i)
#pragma unroll
        for (int e = 0; e < 4; ++e) scr[(8 * i + (lane >> 3)) * 33 + (lane & 7) * 4 + e] = tv[i][e];
    LDS_WAIT(); asm volatile("" ::: "memory");
    const int c = lane & 7;
#pragma unroll
    for (int j = 0; j < 4; ++j) { const int n = (lane >> 3) + 8 * j; const LAS float* s = scr + (8 * c) * 33 + n;
        v4u o; o.x = pk2(s[0 * 33], s[1 * 33]); o.y = pk2(s[2 * 33], s[3 * 33]); o.z = pk2(s[4 * 33], s[5 * 33]); o.w = pk2(s[6 * 33], s[7 * 33]);
        if constexpr (SC1) store16_wt((void*)(WT + (size_t)(dst_row0 + n) * ldk + k0 + 8 * c), o);
        else *(GAS v4u*)(WT + (size_t)(dst_row0 + n) * ldk + k0 + 8 * c) = o; }
    LDS_WAIT(); asm volatile("" ::: "memory");
}
__device__ __forceinline__ int crow(int r, int hi) { return (r & 3) + 8 * (r >> 2) + 4 * hi; }

__host__ __device__ __forceinline__ int own_tile(int ts) { const int x = ts >> 4, j = ts & 15, jj = x & 1, qb = j < 8 ? 8 * jj + j : 31 - 8 * jj - (j - 8); return 32 * (x >> 1) + qb; }

namespace pg8 {
#define PG8_LAS __attribute__((address_space(3)))
typedef unsigned short bf16_t;
typedef short bf16x8 __attribute__((ext_vector_type(8)));
typedef float f32x4 __attribute__((ext_vector_type(4)));
typedef unsigned u32x4 __attribute__((ext_vector_type(4)));
constexpr int BM = 256, BK = 64, HALF = 128, HTB = HALF * BK * 2  , STAGE_BYTES = 8 * HTB, NXCD = 8, WGM = 4;

__host__ __device__ __forceinline__ int lds_byte(int r, int c) { const int st = (r >> 4) * 2 + (c >> 5), rr = r & 15, cc = c & 31, ob = rr * 64 + cc * 2; return st * 1024 + (ob ^ (((ob >> 9) & 1) << 5)); }
__host__ __device__ __forceinline__ void stage_rc(int b, int& R, int& C) { const int st = b / 1024, sb = b % 1024, swz = sb ^ (((sb >> 9) & 1) << 5); R = (st >> 1) * 16 + swz / 64; C = (st & 1) * 32 + (swz % 64) / 2; }
__host__ __device__ __forceinline__ int perm32(int rho) { const int n = rho >> 4, i = rho & 15; return 8 * (i >> 2) + 4 * n + (i & 3); }

struct Unit { int pm, pn; };
struct Gemm { const bf16_t* A; const bf16_t* Bt; int M, N, K; };

struct StaticOrder {
    int nM, nN, nwg, G, c;
    __host__ __device__ void init(int M, int N, int G_, int c_) { nM = M / BM; nN = N / BM; nwg = nM * nN; G = G_; c = c_; }
    __host__ __device__ bool next(int i, Unit& u) const {
        const long L = (long)i * G + c; if (L >= nwg) return false;
        int wgid = (int)L; { const int q = nwg / NXCD, r = nwg % NXCD, xcd = wgid % NXCD, off = wgid / NXCD; wgid = (xcd < r ? xcd * (q + 1) : r * (q + 1) + (xcd - r) * q) + off; }
        const int nig = WGM * nN, gid = wgid / nig, fm = gid * WGM, gsz = (nM - fm) < WGM ? (nM - fm) : WGM;
        u.pm = fm + ((wgid % nig) % gsz); u.pn = (wgid % nig) / gsz; return true;
    }
    __device__ __forceinline__ void a_ready(const Unit&) const {}
    __device__ __forceinline__ void done(const Unit&) const {}
};

typedef float f32x2c __attribute__((ext_vector_type(2))); typedef __bf16 bf16x2c __attribute__((ext_vector_type(2)));
__device__ __forceinline__ unsigned cvt_pk_bf16(float lo, float hi) { const f32x2c v = {lo, hi}; const bf16x2c b = __builtin_convertvector(v, bf16x2c); return __builtin_bit_cast(unsigned, b); }
typedef float f32x2 __attribute__((ext_vector_type(2)));

typedef unsigned u32x2 __attribute__((ext_vector_type(2)));
__device__ __forceinline__ u32x4 pack8(const f32x4 a, const f32x4 b) { u32x4 w; w.x = cvt_pk_bf16(a[0], a[1]); w.y = cvt_pk_bf16(a[2], a[3]); w.z = cvt_pk_bf16(b[0], b[1]); w.w = cvt_pk_bf16(b[2], b[3]); return w; }
__device__ __forceinline__ float sigmoidf_fast(float z) { return __builtin_amdgcn_rcpf(1.0f + __expf(-z)); }
struct EpiProj {
    static constexpr bool PERM = true, AFTER_DRAIN = false; static constexpr int RELAX = 8;
    bf16_t *Q, *K, *V, *CB, *U, *G; const float* rope; const float* bgate; float c2;
    __device__ __forceinline__ void operator()(const f32x4 (&acc)[2][2][4][2], const Unit& u, int wr, int wc, int fr, int fq) const {
        const int row0 = u.pm * BM + wr * 64 + fr, tile = u.pn;
        if (tile < 4) {
            bf16_t* dst = (tile < 2 ? Q : K) + ((tile & 1) * 4 + wc) * 64 + 8 * fq; const float sc = tile < 2 ? c2 : 1.f;
#pragma unroll
            for (int ai = 0; ai < 2; ++ai) {
                f32x4 cst[4][4];
#pragma unroll
                for (int m = 0; m < 4; ++m) { const f32x4* cs = (const f32x4*)(rope + (size_t)(row0 + ai * HALF + m * 16) * 64 + 16 * fq);
#pragma unroll
                    for (int q = 0; q < 4; ++q) cst[m][q] = cs[q]; }
#pragma unroll
                for (int m = 0; m < 4; ++m) { const int t = row0 + ai * HALF + m * 16;
                    f32x4 lo[2], hi[2], ol[2], oh[2];
                    lo[0] = acc[ai][0][m][0]; lo[1] = acc[ai][0][m][1]; hi[0] = acc[ai][1][m][0]; hi[1] = acc[ai][1][m][1];
#pragma unroll
                    for (int n = 0; n < 2; ++n) { const f32x4 ca = cst[m][2 * n], cb = cst[m][2 * n + 1];
                        ol[n][0] = (lo[n][0] * ca.x - hi[n][0] * ca.y) * sc; oh[n][0] = (hi[n][0] * ca.x + lo[n][0] * ca.y) * sc;
                        ol[n][1] = (lo[n][1] * ca.z - hi[n][1] * ca.w) * sc; oh[n][1] = (hi[n][1] * ca.z + lo[n][1] * ca.w) * sc;
                        ol[n][2] = (lo[n][2] * cb.x - hi[n][2] * cb.y) * sc; oh[n][2] = (hi[n][2] * cb.x + lo[n][2] * cb.y) * sc;
                        ol[n][3] = (lo[n][3] * cb.z - hi[n][3] * cb.w) * sc; oh[n][3] = (hi[n][3] * cb.z + lo[n][3] * cb.w) * sc; }
                    bf16_t* rowp = dst + (size_t)t * 512;
                    *(u32x4*)rowp = pack8(ol[0], ol[1]); *(u32x4*)(rowp + 32) = pack8(oh[0], oh[1]); } }
        } else if (tile < 8) {
            bf16_t* dst = (tile < 6 ? V : CB) + (tile & 1) * 256 + wc * 32 + 8 * fq;
#pragma unroll
            for (int ai = 0; ai < 2; ++ai)
#pragma unroll
                for (int m = 0; m < 4; ++m) { bf16_t* rowp = dst + (size_t)(row0 + ai * HALF + m * 16) * 512;
#pragma unroll
                    for (int bj = 0; bj < 2; ++bj) *(u32x4*)(rowp + bj * HALF) = pack8(acc[ai][bj][m][0], acc[ai][bj][m][1]); }
        } else if (tile < 12) {
            bf16_t* dst = U + (tile - 8) * 128 + wc * 32 + 8 * fq;
#pragma unroll
            for (int ai = 0; ai < 2; ++ai)
#pragma unroll
                for (int m = 0; m < 4; ++m) *(u32x4*)(dst + (size_t)(row0 + ai * HALF + m * 16) * 512) = pack8(acc[ai][0][m][0] * acc[ai][1][m][0], acc[ai][0][m][1] * acc[ai][1][m][1]);
        } else {
            const int c0 = (tile - 12) * 128 + wc * 32 + 8 * fq;
            f32x4 bv[2][2];
#pragma unroll
            for (int bj = 0; bj < 2; ++bj)
#pragma unroll
                for (int n = 0; n < 2; ++n) bv[bj][n] = *(const f32x4*)(bgate + bj * 1024 + c0 + 4 * n);
#pragma unroll
            for (int ai = 0; ai < 2; ++ai)
#pragma unroll
                for (int m = 0; m < 4; ++m) { bf16_t* rowp = G + (size_t)(row0 + ai * HALF + m * 16) * 2048 + c0;
                    f32x4 g[2], r[2];
#pragma unroll
                    for (int n = 0; n < 2; ++n) { const f32x4 z0 = acc[ai][0][m][n] + bv[0][n], z1 = acc[ai][1][m][n] + bv[1][n];
#pragma unroll
                        for (int e = 0; e < 4; ++e) { const float u0 = 1.0f + __expf(-z0[e]), g1 = __builtin_amdgcn_rcpf(1.0f + __expf(-z1[e]));
                            g[n][e] = __builtin_fmaxf(__builtin_amdgcn_rcpf(u0), 9.5367431640625e-07f); r[n][e] = __builtin_fminf(u0, 1048576.0f) * g1; } }
                    *(u32x4*)rowp = pack8(g[0], g[1]); *(u32x4*)(rowp + 1024) = pack8(r[0], r[1]); }
        }
    }
};
template <class Epi, class Sched, bool ALIGN_EPI = false, bool SP2 = false>
__device__ __forceinline__ void gemm_phase(PG8_LAS unsigned char* lds, const Gemm g, const Sched& S, const Epi& E, const int wid_in) {
    int tid_ = wid_in * 64 + (int)__builtin_amdgcn_mbcnt_hi(~0u, __builtin_amdgcn_mbcnt_lo(~0u, 0u)); asm volatile("" : "+v"(tid_));
    const int tid = tid_, wid = __builtin_amdgcn_readfirstlane(tid >> 6), lane = tid & 63, wr = wid >> 2, wc = wid & 3, fr = lane & 15, fq = lane >> 4;
    const int K = g.K, nt = K / BK;
    unsigned voffA[2], voffB[2];
#pragma unroll
    for (int i = 0; i < 2; ++i) { int R, C; stage_rc(tid * 16 + i * 8192, R, C); const int Rb = Epi::PERM ? ((R & ~31) + perm32(R & 31)) : R;
        voffA[i] = (unsigned)(R * K + C) * 2u; voffB[i] = (unsigned)(Rb * K + C) * 2u; }
    const size_t kstep = (size_t)(BK * 2);
    const size_t hstep = (size_t)HALF * K * 2;
    const size_t tstep = 2 * hstep;
    const unsigned ldsw = (unsigned)wid * 1024u;
    const int aoff = lds_byte(wr * 64 + fr, fq * 8), boff = lds_byte(wc * 32 + fr, fq * 8);
#define PG8_SA(b, h) (((b) * 2 + (h)) * HTB)
#define PG8_SB(b, h) ((4 + (b) * 2 + (h)) * HTB)
#define PG8_STAGE(bufoff, gbase, voff) do { _Pragma("unroll") for (int _i = 0; _i < 2; ++_i) \
        __builtin_amdgcn_global_load_lds((const unsigned*)((const char*)(gbase) + (voff)[_i]), (PG8_LAS unsigned*)(lds + (bufoff) + ldsw + _i * 8192), 16, 0, 0); } while (0)
#define PG8_LDA(dst, b, h) do { _Pragma("unroll") for (int m = 0; m < 4; ++m) _Pragma("unroll") for (int k = 0; k < 2; ++k) dst[m][k] = *(const PG8_LAS bf16x8*)(lds + PG8_SA(b, h) + aoff + m * 2048 + k * 1024); } while (0)
#define PG8_LDB(dst, b, h) do { _Pragma("unroll") for (int n = 0; n < 2; ++n) _Pragma("unroll") for (int k = 0; k < 2; ++k) dst[n][k] = *(const PG8_LAS bf16x8*)(lds + PG8_SB(b, h) + boff + n * 2048 + k * 1024); } while (0)
#define PG8_MMA(ai, bj, At, Bt) do { __builtin_amdgcn_s_setprio(1); _Pragma("unroll") for (int m = 0; m < 4; ++m) _Pragma("unroll") for (int n = 0; n < 2; ++n) _Pragma("unroll") for (int k = 0; k < 2; ++k) \
        acc[ai][bj][m][n] = __builtin_amdgcn_mfma_f32_16x16x32_bf16(Bt[n][k], At[m][k], acc[ai][bj][m][n], 0, 0, 0); __builtin_amdgcn_s_setprio(0); } while (0)
#define PG8_WAIT_V(n) asm volatile("s_waitcnt vmcnt(" #n ")" ::: "memory")
#define PG8_WAIT_VR(flag) do { static_assert(Epi::RELAX == 0 || Epi::RELAX == 8, "one relaxed count is written out"); \
        if constexpr (Epi::RELAX == 8) { const int f_ = __builtin_amdgcn_readfirstlane(flag); asm volatile("s_cmp_eq_u32 %0, 0\n\ts_cbranch_scc1 .Lwr%=\n\ts_waitcnt vmcnt(16)\n\ts_branch .Lwe%=\n.Lwr%=:\n\ts_waitcnt vmcnt(8)\n.Lwe%=:" :: "s"(f_) : "scc", "memory"); } \
        else asm volatile("s_waitcnt vmcnt(8)" ::: "memory"); } while (0)
#define PG8_WAIT_L(n) asm volatile("s_waitcnt lgkmcnt(" #n ")" ::: "memory")
#define PG8_BAR __builtin_amdgcn_s_barrier()
#define PG8_SCHED __builtin_amdgcn_sched_barrier(0)
    Unit cur, nxt; int ui = 0;
    if (!S.next(0, cur)) return;
    f32x4 acc[2][2][4][2];
#pragma unroll
    for (int a = 0; a < 2; ++a)
#pragma unroll
        for (int b = 0; b < 2; ++b)
#pragma unroll
            for (int m = 0; m < 4; ++m)
#pragma unroll
                for (int n = 0; n < 2; ++n) acc[a][b][m][n] = (f32x4){0.f, 0.f, 0.f, 0.f};
    bf16x8 At[4][2], B0[2][2], B1[2][2];
    const char* cA = (const char*)g.A + (size_t)cur.pm * tstep; const char* cB = (const char*)g.Bt + (size_t)cur.pn * tstep;
    S.a_ready(cur);
    if constexpr (SP2) {
        PG8_STAGE(PG8_SB(0, 0), cB, voffB); PG8_STAGE(PG8_SB(0, 1), cB + hstep, voffB); PG8_STAGE(PG8_SA(0, 0), cA, voffA); PG8_STAGE(PG8_SA(0, 1), cA + hstep, voffA);
        if (wr == 1) PG8_BAR;
        PG8_WAIT_V(2); PG8_BAR;
        PG8_STAGE(PG8_SB(1, 0), cB + kstep, voffB); PG8_STAGE(PG8_SA(1, 0), cA + kstep, voffA); PG8_STAGE(PG8_SB(1, 1), cB + hstep + kstep, voffB);
        PG8_WAIT_V(6); PG8_BAR;
    } else {
        PG8_STAGE(PG8_SB(0, 0), cB, voffB); PG8_STAGE(PG8_SA(0, 0), cA, voffA); PG8_STAGE(PG8_SB(0, 1), cB + hstep, voffB); PG8_STAGE(PG8_SA(0, 1), cA + hstep, voffA);
        if (wr == 1) PG8_BAR;
        PG8_WAIT_V(4); PG8_BAR;
        PG8_STAGE(PG8_SB(1, 0), cB + kstep, voffB); PG8_STAGE(PG8_SA(1, 0), cA + kstep, voffA); PG8_STAGE(PG8_SB(1, 1), cB + hstep + kstep, voffB);
        PG8_WAIT_V(6); PG8_BAR;
    }
    for (;;) {
        const bool has_next = S.next(ui + 1, nxt);
        const char* nA = has_next ? (const char*)g.A + (size_t)nxt.pm * tstep : cA; const char* nB = has_next ? (const char*)g.Bt + (size_t)nxt.pn * tstep : cB;
        for (int t = 0; t < nt; t += 2) {
            const bool last = (t == nt - 2);
            const char* a1 = cA + (size_t)(t + 1) * kstep;
            const char* a2 = last ? nA : cA + (size_t)(t + 2) * kstep; const char* b2 = last ? nB : cB + (size_t)(t + 2) * kstep;
            const char* a3 = a2 + kstep; const char* b3 = b2 + kstep;
            if (last && has_next) S.a_ready(nxt);
            if constexpr (SP2) {
            PG8_LDB(B0, 0, 0); PG8_LDB(B1, 0, 1); PG8_SCHED; PG8_LDA(At, 0, 0); PG8_STAGE(PG8_SA(1, 1), a1 + hstep, voffA);
            PG8_WAIT_VR((t == 0 && ui > 0) ? 1 : 0); PG8_WAIT_L(0); PG8_BAR; PG8_MMA(0, 0, At, B0); PG8_MMA(0, 1, At, B1); PG8_BAR; PG8_SCHED;
            PG8_LDA(At, 0, 1); PG8_STAGE(PG8_SB(0, 0), b2, voffB); PG8_STAGE(PG8_SB(0, 1), b2 + hstep, voffB); PG8_STAGE(PG8_SA(0, 0), a2, voffA);
            PG8_WAIT_VR((t == 0 && ui > 0) ? 1 : 0); PG8_WAIT_L(0); PG8_BAR; PG8_MMA(1, 0, At, B0); PG8_MMA(1, 1, At, B1); PG8_BAR; PG8_SCHED;
            PG8_LDB(B0, 1, 0); PG8_LDB(B1, 1, 1); PG8_SCHED; PG8_LDA(At, 1, 0); PG8_STAGE(PG8_SA(0, 1), a2 + hstep, voffA);
            PG8_WAIT_V(8); PG8_WAIT_L(0); PG8_BAR; PG8_MMA(0, 0, At, B0); PG8_MMA(0, 1, At, B1); PG8_BAR; PG8_SCHED;
            PG8_LDA(At, 1, 1); PG8_STAGE(PG8_SB(1, 0), b3, voffB); PG8_STAGE(PG8_SB(1, 1), b3 + hstep, voffB); PG8_STAGE(PG8_SA(1, 0), a3, voffA);
            PG8_WAIT_V(8); PG8_WAIT_L(0); PG8_BAR; PG8_MMA(1, 0, At, B0); PG8_MMA(1, 1, At, B1); PG8_BAR; PG8_SCHED;
            } else {
            PG8_LDB(B0, 0, 0); PG8_SCHED; PG8_LDA(At, 0, 0); PG8_STAGE(PG8_SA(1, 1), a1 + hstep, voffA);
            PG8_WAIT_L(8); PG8_BAR; PG8_WAIT_L(0); PG8_MMA(0, 0, At, B0); PG8_BAR; PG8_SCHED;
            PG8_LDB(B1, 0, 1); PG8_STAGE(PG8_SB(0, 0), b2, voffB);
            PG8_BAR; PG8_WAIT_L(0); PG8_MMA(0, 1, At, B1); PG8_BAR;
            PG8_LDA(At, 0, 1); PG8_STAGE(PG8_SA(0, 0), a2, voffA);
            PG8_BAR; PG8_WAIT_L(0); PG8_MMA(1, 0, At, B0); PG8_BAR; PG8_SCHED;
            PG8_STAGE(PG8_SB(0, 1), b2 + hstep, voffB);
            PG8_WAIT_V(6); PG8_BAR; PG8_MMA(1, 1, At, B1); PG8_BAR;
            PG8_LDB(B0, 1, 0); PG8_SCHED; PG8_LDA(At, 1, 0); PG8_STAGE(PG8_SA(0, 1), a2 + hstep, voffA);
            PG8_WAIT_L(8); PG8_BAR; PG8_WAIT_L(0); PG8_MMA(0, 0, At, B0); PG8_BAR; PG8_SCHED;
            PG8_LDB(B1, 1, 1); PG8_STAGE(PG8_SB(1, 0), b3, voffB);
            PG8_BAR; PG8_WAIT_L(0); PG8_MMA(0, 1, At, B1); PG8_BAR;
            PG8_LDA(At, 1, 1); PG8_STAGE(PG8_SA(1, 0), a3, voffA);
            PG8_BAR; PG8_WAIT_L(0); PG8_MMA(1, 0, At, B0); PG8_BAR; PG8_SCHED;
            PG8_STAGE(PG8_SB(1, 1), b3 + hstep, voffB);
            PG8_WAIT_V(6); PG8_BAR; PG8_MMA(1, 1, At, B1); PG8_BAR;
            }
        }
        if constexpr (ALIGN_EPI) { if (wr == 0) PG8_BAR; }
        if constexpr (!Epi::AFTER_DRAIN) { E(acc, cur, wr, wc, fr, fq); S.done(cur); }
        if (!has_next) break;
#pragma unroll
        for (int a = 0; a < 2; ++a)
#pragma unroll
            for (int b = 0; b < 2; ++b)
#pragma unroll
                for (int m = 0; m < 4; ++m)
#pragma unroll
                    for (int n = 0; n < 2; ++n) acc[a][b][m][n] = (f32x4){0.f, 0.f, 0.f, 0.f};
        cur = nxt; cA = nA; cB = nB; ++ui;
        if constexpr (ALIGN_EPI) { if (wr == 1) PG8_BAR; }
    }
    PG8_WAIT_V(0);
    if constexpr (!ALIGN_EPI) { if (wr == 0) PG8_BAR; }
    PG8_BAR;
    if constexpr (Epi::AFTER_DRAIN) { E.fused(acc, cur, wr, wc, fr, fq, lds, wid, lane); S.done(cur); }
#undef PG8_SA
#undef PG8_SB
#undef PG8_STAGE
#undef PG8_LDA
#undef PG8_LDB
#undef PG8_MMA
#undef PG8_WAIT_V
#undef PG8_WAIT_VR
#undef PG8_WAIT_L
#undef PG8_BAR
#undef PG8_SCHED
}
}


namespace pg8 {
struct Unit2 { int pm, pn; int arow; int e; int r0; int nv; int rtg; };
struct PlainSrc : StaticOrder {
    int rev = 0;
    __device__ __forceinline__ bool next(int i, Unit2& u) const { Unit t; const int nc = c < nwg ? (nwg - 1 - c) / G + 1 : 0; if (i >= nc) return false; if (!StaticOrder::next(rev ? nc - 1 - i : i, t)) return false; u.pm = own_tile(t.pm); u.pn = t.pn; u.arow = u.pm * BM; u.e = 0; u.r0 = 0; u.nv = BM; u.rtg = 0; return true; }
    static constexpr bool PUBLISH = false; static constexpr int A_AUX = 0; static constexpr size_t A_KSTEP = BK * 2;
    __device__ __forceinline__ void publish(int, int) const {}
    __device__ __forceinline__ void a_issue(const Unit2&, const int (&)[2], int (&)[2][2]) const {}
    __device__ __forceinline__ const char* a_finish(const Gemm& g, const Unit2& u, const int (&R)[2], const int (&C)[2], const int (&)[2][2], unsigned (&v)[2][2]) const {
#pragma unroll
        for (int h = 0; h < 2; ++h)
#pragma unroll
            for (int i = 0; i < 2; ++i) v[h][i] = (unsigned)((h * HALF + R[i]) * g.K + C[i]) * 2u;
        return (const char*)g.A + (size_t)u.arow * g.K * 2;
    }
};
constexpr unsigned HM_STRIPB = 256u * 64u, HM_TILEB = 16u * HM_STRIPB;
constexpr int RDY_STRIDE = 16, RDY_TARGET = 32, RDY_SPIN_CAP = 1 << 22;
template <int STAGE> struct MoeSrc {
    static constexpr bool PUBLISH = (STAGE == 0); static constexpr int A_AUX = 0; static constexpr size_t A_KSTEP = (STAGE == 1) ? 2 * (size_t)HM_STRIPB : (size_t)(BK * 2);
    int G, c, ntn; const int2* list; PG8_LAS int* tab; unsigned* rdy;
    int r8, gapn, q, r9, cc, hasgap;
    __device__ __forceinline__ void init(const unsigned* cnt, PG8_LAS int* tab_, int G_, int c_, int ntn_, const int2* list_, unsigned* rdy_, int wid) {
        G = G_; c = c_; ntn = ntn_; list = list_; tab = tab_; rdy = rdy_;
        if constexpr (STAGE == 0) {
        if (wid == 0) { const int lane = (int)__builtin_amdgcn_mbcnt_hi(~0u, __builtin_amdgcn_mbcnt_lo(~0u, 0u));
            const int a = (lane < 32) ? (int)__hip_atomic_load(cnt + lane, __ATOMIC_RELAXED, __HIP_MEMORY_SCOPE_AGENT) : 0, t4 = ((a + BM - 1) / BM) * ntn_;
            int ia = a, it = t4;
#pragma unroll
            for (int o = 1; o < 32; o <<= 1) { const int x = __shfl_up(ia, o), y = __shfl_up(it, o); if ((lane & 31) >= o) { ia += x; it += y; } }
            if (lane < 32) { tab_[4 * lane] = a; tab_[4 * lane + 1] = ia - a; tab_[4 * lane + 2] = it; tab_[4 * lane + 3] = it - t4; } }
        __syncthreads();
        r8 = gapn = q = r9 = cc = hasgap = 0;
        } else {
            const int n = __builtin_amdgcn_readfirstlane(tab_[4 * 31 + 2]);
            r8 = n % G_; const int gap = r8 ? G_ - r8 : 0; gapn = gap < n ? gap : n; const int n9 = n - gapn; q = n9 / G_; r9 = n9 - q * G_;
            cc = r8 ? (c_ - r8 + G_) % G_ : c_; hasgap = (r8 > 0 && c_ >= r8 && c_ - r8 < n) ? 1 : 0;
        }
    }
    __device__ __forceinline__ bool next(int i, Unit2& u) const {
        const int total = tab[4 * 31 + 2]; int L;
        if constexpr (STAGE == 0) { L = i * G + c; if (L >= total) return false; }
        else { int ii = i - hasgap;
            if (ii < 0) L = c - r8; else if (ii < q) L = gapn + ii * G + c; else if (ii == q && cc < r9) L = gapn + q * G + cc; else return false; }
        const int lane = (int)__builtin_amdgcn_mbcnt_hi(~0u, __builtin_amdgcn_mbcnt_lo(~0u, 0u)); const int inc = tab[4 * (lane & 31) + 2];
        const unsigned long long m = __ballot(lane < 32 && L >= inc); const int e = __builtin_amdgcn_readfirstlane(__popcll(m));
        const int cnt = __builtin_amdgcn_readfirstlane(tab[4 * e]), ex = __builtin_amdgcn_readfirstlane(tab[4 * e + 1]), ux = __builtin_amdgcn_readfirstlane(tab[4 * e + 3]), l0 = L - ux;
        const int rt = l0 / ntn, pn = l0 - rt * ntn;
        u.e = e; u.pm = rt; u.pn = e * ntn + pn; u.r0 = rt * BM; u.nv = (cnt - rt * BM) < BM ? (cnt - rt * BM) : BM; u.arow = ex + rt * BM; u.rtg = ux / ntn + rt; return true;
    }
    __device__ __forceinline__ void publish(int rtg, int lane) const { if (lane == 0) (void)__hip_atomic_fetch_add(rdy + rtg * RDY_STRIDE, 1u, __ATOMIC_RELAXED, __HIP_MEMORY_SCOPE_AGENT); }
    __device__ __forceinline__ void a_issue(const Unit2& u, const int (&R)[2], int (&aid)[2][2]) const {
        if constexpr (STAGE == 0) {
#pragma unroll
            for (int h = 0; h < 2; ++h)
#pragma unroll
                for (int i = 0; i < 2; ++i) { int r = h * HALF + R[i]; r = r < u.nv ? r : u.nv - 1; aid[h][i] = list[u.e * 32768 + u.r0 + r].x; }
        } else aid[0][0] = (int)__hip_atomic_load(rdy + u.rtg * RDY_STRIDE, __ATOMIC_RELAXED, __HIP_MEMORY_SCOPE_AGENT);
    }
    __device__ __forceinline__ const char* a_finish(const Gemm& g, const Unit2& u, const int (&R)[2], const int (&C)[2], const int (&aid)[2][2], unsigned (&v)[2][2]) const {
        if constexpr (STAGE == 0) {
#pragma unroll
            for (int h = 0; h < 2; ++h)
#pragma unroll
                for (int i = 0; i < 2; ++i) v[h][i] = ((unsigned)(aid[h][i] >> 1) * (unsigned)g.K + (unsigned)C[i]) * 2u;
            return (const char*)g.A;
        } else {
            int seen = __builtin_amdgcn_readfirstlane(aid[0][0]);
            if (seen < RDY_TARGET) { int sp = 0;
                do { __builtin_amdgcn_s_sleep(2); seen = __builtin_amdgcn_readfirstlane((int)__hip_atomic_load(rdy + u.rtg * RDY_STRIDE, __ATOMIC_RELAXED, __HIP_MEMORY_SCOPE_AGENT)); } while (seen < RDY_TARGET && ++sp < RDY_SPIN_CAP); }
#pragma unroll
            for (int h = 0; h < 2; ++h)
#pragma unroll
                for (int i = 0; i < 2; ++i) { int r = h * HALF + R[i]; r = r < u.nv ? r : u.nv - 1; v[h][i] = (unsigned)(C[i] >> 5) * HM_STRIPB + (unsigned)(r * 64 + (C[i] & 31) * 2); }
            return (const char*)g.A + (size_t)u.rtg * HM_TILEB;
        }
    }
};
__device__ __forceinline__ void unpack8(const u32x4 w, f32x4& a, f32x4& b) { a[0] = __uint_as_float(w.x << 16); a[1] = __uint_as_float(w.x & 0xffff0000u); a[2] = __uint_as_float(w.y << 16); a[3] = __uint_as_float(w.y & 0xffff0000u);
    b[0] = __uint_as_float(w.z << 16); b[1] = __uint_as_float(w.z & 0xffff0000u); b[2] = __uint_as_float(w.w << 16); b[3] = __uint_as_float(w.w & 0xffff0000u); }
template <bool ACCUM> struct EpiGate {
    static constexpr bool PERM = true, AFTER_DRAIN = false, HAS_MID = false; static constexpr int RELAX = 0;
    bf16_t* MGp; const bf16_t* Gp; int goff;
    __device__ __forceinline__ void operator()(const f32x4 (&acc)[2][2][4][2], const Unit2& u, int wr, int wc, int fr, int fq) const {
        const int row0 = u.pm * BM + wr * 64 + fr, col0 = (u.pn & 3) * BM + wc * 32 + 8 * fq;
#pragma unroll
        for (int ai = 0; ai < 2; ++ai)
#pragma unroll
        for (int mh = 0; mh < (ACCUM ? 2 : 1); ++mh) {
            constexpr int MB = ACCUM ? 2 : 4; const int m0 = mh * MB;
            u32x4 gw[4][2], ow[4][2];
#pragma unroll
            for (int m = m0; m < m0 + MB; ++m) { const size_t t = (size_t)(row0 + ai * HALF + m * 16);
#pragma unroll
                for (int bj = 0; bj < 2; ++bj) { gw[m][bj] = *(const u32x4*)(Gp + t * 2048 + goff + col0 + bj * HALF); if (ACCUM) ow[m][bj] = *(const u32x4*)(MGp + t * 1024 + col0 + bj * HALF); } }
#pragma unroll
            for (int m = m0; m < m0 + MB; ++m) { const size_t t = (size_t)(row0 + ai * HALF + m * 16);
#pragma unroll
                for (int bj = 0; bj < 2; ++bj) { f32x4 g0, g1; unpack8(gw[m][bj], g0, g1);
                    f32x4 v0 = acc[ai][bj][m][0] * g0, v1 = acc[ai][bj][m][1] * g1;
                    if (ACCUM) { f32x4 o0, o1; unpack8(ow[m][bj], o0, o1); v0 += o0; v1 += o1; }
                    *(u32x4*)(MGp + t * 1024 + col0 + bj * HALF) = pack8(v0, v1); } } }
    }
};
struct EpiMerge {
    static constexpr bool PERM = true, AFTER_DRAIN = false, HAS_MID = true; static constexpr int RELAX = 8;
    bf16_t* MGp; const bf16_t* Gp;
    __device__ __forceinline__ void mid(f32x4 (&acc)[2][2][4][2], const Unit2& u, int wr, int wc, int fr, int fq) const {
        int row0 = u.pm * BM + wr * 64 + fr, col0 = (u.pn & 3) * BM + wc * 32 + 8 * fq; asm volatile("" : "+v"(row0), "+v"(col0));
        u32x4 rw[2][4][2];
#pragma unroll
        for (int ai = 0; ai < 2; ++ai)
#pragma unroll
            for (int m = 0; m < 4; ++m) { const size_t t = (size_t)(row0 + ai * HALF + m * 16);
#pragma unroll
                for (int bj = 0; bj < 2; ++bj) rw[ai][m][bj] = *(const u32x4*)(Gp + t * 2048 + 1024 + col0 + bj * HALF); }
#pragma unroll
        for (int ai = 0; ai < 2; ++ai)
#pragma unroll
            for (int m = 0; m < 4; ++m)
#pragma unroll
                for (int bj = 0; bj < 2; ++bj) { f32x4 b0, b1; unpack8(rw[ai][m][bj], b0, b1); acc[ai][bj][m][0] *= b0; acc[ai][bj][m][1] *= b1; }
        asm volatile("" ::: "memory");
    }
    __device__ __forceinline__ void operator()(const f32x4 (&acc)[2][2][4][2], const Unit2& u, int wr, int wc, int fr, int fq) const {
        const int row0 = u.pm * BM + wr * 64 + fr, col0 = (u.pn & 3) * BM + wc * 32 + 8 * fq;
#pragma unroll
        for (int ai = 0; ai < 2; ++ai) {
            u32x4 g0w[4][2];
#pragma unroll
            for (int m = 0; m < 4; ++m)
#pragma unroll
                for (int bj = 0; bj < 2; ++bj) g0w[m][bj] = *(const u32x4*)(Gp + (size_t)(row0 + ai * HALF + m * 16) * 2048 + col0 + bj * HALF);
#pragma unroll
            for (int m = 0; m < 4; ++m)
#pragma unroll
                for (int bj = 0; bj < 2; ++bj) { f32x4 a0, a1; unpack8(g0w[m][bj], a0, a1);
#pragma unroll
                    for (int e = 0; e < 4; ++e) { a0[e] = __builtin_fmaxf(a0[e], 9.5367431640625e-07f); a1[e] = __builtin_fmaxf(a1[e], 9.5367431640625e-07f); }
                    *(u32x4*)(MGp + (size_t)(row0 + ai * HALF + m * 16) * 1024 + col0 + bj * HALF) = pack8(acc[ai][bj][m][0] * a0, acc[ai][bj][m][1] * a1); } }
    }
};
struct EpiRes {
    static constexpr bool PERM = false, AFTER_DRAIN = false, HAS_MID = false; static constexpr int RELAX = 0;
    const float* x; float* out; float alpha;
    __device__ __forceinline__ void operator()(const f32x4 (&acc)[2][2][4][2], const Unit2& u, int wr, int wc, int fr, int fq) const {
        const int row0 = u.pm * BM + wr * 64 + fr, col0 = u.pn * BM + wc * 32 + 4 * fq;
#pragma unroll
        for (int ai = 0; ai < 2; ++ai)
#pragma unroll
            for (int m = 0; m < 4; ++m) { const size_t off = (size_t)(row0 + ai * HALF + m * 16) * 1024 + col0;
#pragma unroll
                for (int bj = 0; bj < 2; ++bj)
#pragma unroll
                    for (int n = 0; n < 2; ++n) { const f32x4 xv = *(const f32x4*)(x + off + bj * HALF + n * 16); *(f32x4*)(out + off + bj * HALF + n * 16) = xv * alpha + acc[ai][bj][m][n]; } }
    }
};
struct EpiResB {
    static constexpr bool PERM = true, AFTER_DRAIN = false, HAS_MID = false; static constexpr int RELAX = 8;
    bf16_t* xb; float alpha;
    __device__ __forceinline__ void operator()(const f32x4 (&acc)[2][2][4][2], const Unit2& u, int wr, int wc, int fr, int fq) const {
        const int row0 = u.pm * BM + wr * 64 + fr, col0 = u.pn * BM + wc * 32 + 8 * fq;
#pragma unroll
        for (int ai = 0; ai < 2; ++ai) {
            u32x4 xw[4][2];
#pragma unroll
            for (int m = 0; m < 4; ++m)
#pragma unroll
                for (int bj = 0; bj < 2; ++bj) xw[m][bj] = *(const u32x4*)(xb + (size_t)(row0 + ai * HALF + m * 16) * 1024 + col0 + bj * HALF);
#pragma unroll
            for (int m = 0; m < 4; ++m) { bf16_t* p = xb + (size_t)(row0 + ai * HALF + m * 16) * 1024 + col0;
#pragma unroll
                for (int bj = 0; bj < 2; ++bj) { f32x4 x0, x1; unpack8(xw[m][bj], x0, x1);
                    *(u32x4*)(p + bj * HALF) = pack8(x0 * alpha + acc[ai][bj][m][0], x1 * alpha + acc[ai][bj][m][1]); } } }
    }
};
struct EpiSwiglu {
    static constexpr bool PERM = true, AFTER_DRAIN = false, HAS_MID = false; static constexpr int RELAX = 0;
    bf16_t* HMp;
    __device__ __forceinline__ void operator()(const f32x4 (&acc)[2][2][4][2], const Unit2& u, int wr, int wc, int fr, int fq) const {
        const int rl0 = wr * 64 + fr, col0 = (u.pn & 3) * 128 + wc * 32 + 8 * fq;
        const __amdgpu_buffer_rsrc_t rs = __builtin_amdgcn_make_buffer_rsrc((void*)HMp, 0, 0x7ffffff0, 0x00020000);
#pragma unroll
        for (int ai = 0; ai < 2; ++ai)
#pragma unroll
            for (int m = 0; m < 4; ++m) { const int rl = rl0 + ai * HALF + m * 16;
                if (rl < u.nv) { f32x4 h0, h1;
#pragma unroll
                    for (int e = 0; e < 4; ++e) { const float g0 = acc[ai][0][m][0][e], g1 = acc[ai][0][m][1][e];
                        h0[e] = g0 * sigmoidf_fast(g0) * acc[ai][1][m][0][e]; h1[e] = g1 * sigmoidf_fast(g1) * acc[ai][1][m][1][e]; }
                    __builtin_amdgcn_raw_buffer_store_b128(pack8(h0, h1), rs, (unsigned)u.rtg * HM_TILEB + (unsigned)(col0 >> 5) * HM_STRIPB + (unsigned)(rl * 64 + (col0 & 31) * 2), 0, 16); } }
    }
};
struct EpiDown {
    static constexpr bool PERM = true, AFTER_DRAIN = false, HAS_MID = false; static constexpr int RELAX = 0;
    bf16_t* YSp; const int2* list;
    __device__ __forceinline__ void operator()(const f32x4 (&acc)[2][2][4][2], const Unit2& u, int wr, int wc, int fr, int fq) const {
        const int rl0 = wr * 64 + fr, col0 = (u.pn & 3) * BM + wc * 32 + 8 * fq;
        int aid[2][4]; float w[2][4];
#pragma unroll
        for (int ai = 0; ai < 2; ++ai)
#pragma unroll
            for (int m = 0; m < 4; ++m) { int rl = rl0 + ai * HALF + m * 16; rl = rl < u.nv ? rl : u.nv - 1; const int2 en = list[u.e * 32768 + u.r0 + rl]; aid[ai][m] = en.x; w[ai][m] = __int_as_float(en.y); }
#pragma unroll
        for (int ai = 0; ai < 2; ++ai)
#pragma unroll
            for (int m = 0; m < 4; ++m) { const int rl = rl0 + ai * HALF + m * 16;
                if (rl < u.nv) { bf16_t* p = YSp + (size_t)aid[ai][m] * 1024 + col0;
#pragma unroll
                    for (int bj = 0; bj < 2; ++bj) *(u32x4*)(p + bj * HALF) = pack8(acc[ai][bj][m][0] * w[ai][m], acc[ai][bj][m][1] * w[ai][m]); } }
    }
};
template <class Epi, class Sched, bool ALIGN_EPI = true>
__device__ __forceinline__ void gemm_phase2(PG8_LAS unsigned char* lds, const Gemm g, const Sched& S, const Epi& E, const int wid_in) {
    constexpr bool SP2 = true;
    int tid_ = wid_in * 64 + (int)__builtin_amdgcn_mbcnt_hi(~0u, __builtin_amdgcn_mbcnt_lo(~0u, 0u)); asm volatile("" : "+v"(tid_));
    const int tid = tid_, wid = __builtin_amdgcn_readfirstlane(tid >> 6), lane = tid & 63, wr = wid >> 2, wc = wid & 3, fr = lane & 15, fq = lane >> 4;
    const int K = g.K, nt = K / BK;
    unsigned voffB[2]; int RA[2], CA[2];
#pragma unroll
    for (int i = 0; i < 2; ++i) { int R, C; stage_rc(tid * 16 + i * 8192, R, C); const int Rb = Epi::PERM ? ((R & ~31) + perm32(R & 31)) : R;
        RA[i] = R; CA[i] = C; voffB[i] = (unsigned)(Rb * K + C) * 2u; }
    const size_t kstep = (size_t)(BK * 2);
    const size_t kstepA = Sched::A_KSTEP;
    const size_t hstep = (size_t)HALF * K * 2;
    const size_t tstep = 2 * hstep;
    const unsigned ldsw = (unsigned)wid * 1024u;
    const int aoff = lds_byte(wr * 64 + fr, fq * 8), boff = lds_byte(wc * 32 + fr, fq * 8);
#define PG8_SA(b, h) (((b) * 2 + (h)) * HTB)
#define PG8_SB(b, h) ((4 + (b) * 2 + (h)) * HTB)
#define PG8_STAGE(bufoff, gbase, voff) do { _Pragma("unroll") for (int _i = 0; _i < 2; ++_i) \
        __builtin_amdgcn_global_load_lds((const unsigned*)((const char*)(gbase) + (voff)[_i]), (PG8_LAS unsigned*)(lds + (bufoff) + ldsw + _i * 8192), 16, 0, 0); } while (0)
#define PG8_STAGEA(bufoff, gbase, voff) do { _Pragma("unroll") for (int _i = 0; _i < 2; ++_i) \
        __builtin_amdgcn_global_load_lds((const unsigned*)((const char*)(gbase) + (voff)[_i]), (PG8_LAS unsigned*)(lds + (bufoff) + ldsw + _i * 8192), 16, 0, Sched::A_AUX); } while (0)
#define PG8_LDA(dst, b, h) do { _Pragma("unroll") for (int m = 0; m < 4; ++m) _Pragma("unroll") for (int k = 0; k < 2; ++k) dst[m][k] = *(const PG8_LAS bf16x8*)(lds + PG8_SA(b, h) + aoff + m * 2048 + k * 1024); } while (0)
#define PG8_LDB(dst, b, h) do { _Pragma("unroll") for (int n = 0; n < 2; ++n) _Pragma("unroll") for (int k = 0; k < 2; ++k) dst[n][k] = *(const PG8_LAS bf16x8*)(lds + PG8_SB(b, h) + boff + n * 2048 + k * 1024); } while (0)
#define PG8_MMA(ai, bj, At, Bt) do { __builtin_amdgcn_s_setprio(1); _Pragma("unroll") for (int m = 0; m < 4; ++m) _Pragma("unroll") for (int n = 0; n < 2; ++n) _Pragma("unroll") for (int k = 0; k < 2; ++k) \
        acc[ai][bj][m][n] = __builtin_amdgcn_mfma_f32_16x16x32_bf16(Bt[n][k], At[m][k], acc[ai][bj][m][n], 0, 0, 0); __builtin_amdgcn_s_setprio(0); } while (0)
#define PG8_WAIT_V(n) asm volatile("s_waitcnt vmcnt(" #n ")" ::: "memory")
#define PG8_WAIT_VR(flag) do { static_assert(Epi::RELAX == 0 || Epi::RELAX == 8, "one relaxed count is written out"); \
        if constexpr (Epi::RELAX == 8) { const int f_ = __builtin_amdgcn_readfirstlane(flag); asm volatile("s_cmp_eq_u32 %0, 0\n\ts_cbranch_scc1 .Lwr%=\n\ts_waitcnt vmcnt(16)\n\ts_branch .Lwe%=\n.Lwr%=:\n\ts_waitcnt vmcnt(8)\n.Lwe%=:" :: "s"(f_) : "scc", "memory"); } \
        else asm volatile("s_waitcnt vmcnt(8)" ::: "memory"); } while (0)
#define PG8_WAIT_L(n) asm volatile("s_waitcnt lgkmcnt(" #n ")" ::: "memory")
#define PG8_BAR __builtin_amdgcn_s_barrier()
#define PG8_SCHED __builtin_amdgcn_sched_barrier(0)
    Unit2 cur, nxt; int ui = 0; int pend = -1;
    if (!S.next(0, cur)) return;
    f32x4 acc[2][2][4][2];
#pragma unroll
    for (int a = 0; a < 2; ++a)
#pragma unroll
        for (int b = 0; b < 2; ++b)
#pragma unroll
            for (int m = 0; m < 4; ++m)
#pragma unroll
                for (int n = 0; n < 2; ++n) acc[a][b][m][n] = (f32x4){0.f, 0.f, 0.f, 0.f};
    bf16x8 At[4][2], B0[2][2], B1[2][2];
    unsigned cvA[2][2];
    const char* cA; { int aid0[2][2]; S.a_issue(cur, RA, aid0); cA = S.a_finish(g, cur, RA, CA, aid0, cvA); } const char* cB = (const char*)g.Bt + (size_t)cur.pn * tstep;
    if constexpr (SP2) {
        PG8_STAGE(PG8_SB(0, 0), cB, voffB); PG8_STAGE(PG8_SB(0, 1), cB + hstep, voffB); PG8_STAGEA(PG8_SA(0, 0), cA, cvA[0]); PG8_STAGEA(PG8_SA(0, 1), cA, cvA[1]);
        if (wr == 1) PG8_BAR;
        PG8_WAIT_V(2); PG8_BAR;
        PG8_STAGE(PG8_SB(1, 0), cB + kstep, voffB); PG8_STAGEA(PG8_SA(1, 0), cA + kstepA, cvA[0]); PG8_STAGE(PG8_SB(1, 1), cB + hstep + kstep, voffB);
        PG8_WAIT_V(6); PG8_BAR;
    }
    for (;;) {
        const bool has_next = S.next(ui + 1, nxt);
        const char* nA = cA; const char* nB = has_next ? (const char*)g.Bt + (size_t)nxt.pn * tstep : cB;
        for (int t = 0; t < nt; t += 2) {
            const bool last = (t == nt - 2);
            const char* a1 = cA + (size_t)(t + 1) * kstepA;
            int aidn[2][2] = {{0, 0}, {0, 0}};
            if constexpr (Sched::PUBLISH) { if (t == 2 && pend >= 0) { S.publish(pend, lane); pend = -1; } }
            if constexpr (Epi::HAS_MID) { if (t == nt / 2) { PG8_SCHED; E.mid(acc, cur, wr, wc, fr, fq); PG8_SCHED; } }
            if (last && has_next) S.a_issue(nxt, RA, aidn);
            if constexpr (SP2) {
            PG8_LDB(B0, 0, 0); PG8_LDB(B1, 0, 1); PG8_SCHED; PG8_LDA(At, 0, 0); PG8_STAGEA(PG8_SA(1, 1), a1, cvA[1]);
            PG8_WAIT_VR((t == 0 && ui > 0) ? 1 : 0); PG8_WAIT_L(0); PG8_BAR; PG8_MMA(0, 0, At, B0); PG8_MMA(0, 1, At, B1); PG8_BAR; PG8_SCHED;
            if (last && has_next) nA = S.a_finish(g, nxt, RA, CA, aidn, cvA);
            const char* a2 = last ? nA : cA + (size_t)(t + 2) * kstepA; const char* b2 = last ? nB : cB + (size_t)(t + 2) * kstep;
            const char* a3 = a2 + kstepA; const char* b3 = b2 + kstep;
            PG8_LDA(At, 0, 1); PG8_STAGE(PG8_SB(0, 0), b2, voffB); PG8_STAGE(PG8_SB(0, 1), b2 + hstep, voffB); PG8_STAGEA(PG8_SA(0, 0), a2, cvA[0]);
            PG8_WAIT_VR((t == 0 && ui > 0) ? 1 : 0); PG8_WAIT_L(0); PG8_BAR; PG8_MMA(1, 0, At, B0); PG8_MMA(1, 1, At, B1); PG8_BAR; PG8_SCHED;
            PG8_LDB(B0, 1, 0); PG8_LDB(B1, 1, 1); PG8_SCHED; PG8_LDA(At, 1, 0); PG8_STAGEA(PG8_SA(0, 1), a2, cvA[1]);
            PG8_WAIT_V(8); PG8_WAIT_L(0); PG8_BAR; PG8_MMA(0, 0, At, B0); PG8_MMA(0, 1, At, B1); PG8_BAR; PG8_SCHED;
            PG8_LDA(At, 1, 1); PG8_STAGE(PG8_SB(1, 0), b3, voffB); PG8_STAGE(PG8_SB(1, 1), b3 + hstep, voffB); PG8_STAGEA(PG8_SA(1, 0), a3, cvA[0]);
            PG8_WAIT_V(8); PG8_WAIT_L(0); PG8_BAR; PG8_MMA(1, 0, At, B0); PG8_MMA(1, 1, At, B1); PG8_BAR; PG8_SCHED;
            }
        }
        if constexpr (ALIGN_EPI) { if (wr == 0) PG8_BAR; }
        E(acc, cur, wr, wc, fr, fq);
        if constexpr (Sched::PUBLISH) pend = cur.rtg;
        if (!has_next) break;
#pragma unroll
        for (int a = 0; a < 2; ++a)
#pragma unroll
            for (int b = 0; b < 2; ++b)
#pragma unroll
                for (int m = 0; m < 4; ++m)
#pragma unroll
                    for (int n = 0; n < 2; ++n) acc[a][b][m][n] = (f32x4){0.f, 0.f, 0.f, 0.f};
        cur = nxt; cA = nA; cB = nB; ++ui;
        if constexpr (ALIGN_EPI) { if (wr == 1) PG8_BAR; }
    }
    PG8_WAIT_V(0);
    if constexpr (Sched::PUBLISH) { if (pend >= 0) S.publish(pend, lane); }
    if constexpr (!ALIGN_EPI) { if (wr == 0) PG8_BAR; }
    PG8_BAR;
#undef PG8_SA
#undef PG8_SB
#undef PG8_STAGE
#undef PG8_STAGEA
#undef PG8_LDA
#undef PG8_LDB
#undef PG8_MMA
#undef PG8_WAIT_V
#undef PG8_WAIT_VR
#undef PG8_WAIT_L
#undef PG8_BAR
#undef PG8_SCHED
}

}
#include <hip/hip_bf16.h>

#define ATTN_STORE16(p,v) (*(u32x4*)(p)=(v))
namespace attn_b {
using bf16=__hip_bfloat16;
using bf16x8=__attribute__((ext_vector_type(8)))short;
using s16x4=__attribute__((ext_vector_type(4)))short;
using f32x16=__attribute__((ext_vector_type(16)))float;
using u32x4=__attribute__((ext_vector_type(4)))unsigned;
constexpr int BATCH=4,SEQ=8192,D=64,QP=512,KP=512,VP=512,OP=1024;
constexpr int NW=8,QBLK=32,QB=QBLK*NW,KVBLK=64,NQB=SEQ/QB;
constexpr int ATTN_UNIT_ROWS=QB;
__device__ __forceinline__ int crow(int r,int hi){return (r&3)+8*(r>>2)+4*hi;}
#define SBAR() __builtin_amdgcn_sched_barrier(0)
__device__ __forceinline__ void cmask(f32x16&p0,f32x16&p1,int jb,int qrel,int hi){
  const float NEG=-INFINITY; int kb=64*jb+4*hi;
  #pragma unroll
  for(int r=0;r<16;++r){int kv=kb+(r&3)+8*(r>>2); if(kv>qrel)p0[r]=NEG; if(kv+32>qrel)p1[r]=NEG;}
}

constexpr int NSLOT=3, SLOTB=8192;
constexpr int LDS_K=0, LDS_V=NSLOT*SLOTB, LDS_WS=3*NSLOT*SLOTB, LDS_OST=LDS_WS+NW*64*4, LDS_BYTES=LDS_OST+NW*4096;
constexpr float C2=0.125f*1.4426950408889634f;
__device__ __forceinline__ void glds16(const void*gbase,unsigned voff,unsigned lds_dst){unsigned keep;
  asm volatile("s_mov_b32 %0, m0\n\ts_mov_b32 m0, %3\n\ts_nop 0\n\tglobal_load_lds_dwordx4 %1, %2\n\ts_mov_b32 m0, %0":"=&s"(keep):"v"(voff),"s"(gbase),"s"(lds_dst):"memory");}
__device__ __forceinline__ float max3f(float a,float b,float c){float r;asm("v_max3_f32 %0, %1, %2, %3":"=v"(r):"v"(a),"v"(b),"v"(c));return r;}
__device__ __forceinline__ float max2f(float a,float b){float r;asm("v_max_f32_e32 %0, %1, %2":"=v"(r):"v"(a),"v"(b));return r;}
__device__ __forceinline__ float fadd_s(float a,float b){float r;asm("v_add_f32_e32 %0, %1, %2":"=v"(r):"v"(a),"v"(b));return r;}
__device__ __forceinline__ float fsub_s(float a,float b){float r;asm("v_sub_f32_e32 %0, %1, %2":"=v"(r):"v"(a),"v"(b));return r;}
typedef float f32x2_t __attribute__((ext_vector_type(2))); typedef __bf16 bf16x2_t __attribute__((ext_vector_type(2)));
__device__ __forceinline__ unsigned cvtpk_s(float lo,float hi){f32x2_t v={lo,hi};bf16x2_t b=__builtin_convertvector(v,bf16x2_t);return __builtin_bit_cast(unsigned,b);}
#define WAIT_BAR(N) asm volatile("s_waitcnt vmcnt(" #N ") lgkmcnt(0)\n\ts_barrier":::"memory")

__device__ __forceinline__ void qkt(f32x16&p0,f32x16&p1,const char*Kslot,const bf16x8*qr,int r32,int hi){ const f32x16 zz=f32x16{};
  const char*kb=Kslot+hi*1024+r32*16;
  #pragma unroll
  for(int d0=0;d0<4;++d0){
    const bf16x8 b0=*reinterpret_cast<const bf16x8*>(kb+d0*2048);
    const bf16x8 b1=*reinterpret_cast<const bf16x8*>(kb+d0*2048+512);
    if(d0==0){p0=__builtin_amdgcn_mfma_f32_32x32x16_bf16(b0,qr[0],zz,0,0,0);p1=__builtin_amdgcn_mfma_f32_32x32x16_bf16(b1,qr[0],zz,0,0,0);}
    else{p0=__builtin_amdgcn_mfma_f32_32x32x16_bf16(b0,qr[d0],p0,0,0,0);p1=__builtin_amdgcn_mfma_f32_32x32x16_bf16(b1,qr[d0],p1,0,0,0);}}
}
typedef __attribute__((address_space(3))) const char* lds_cptr;
typedef short v4i16_t __attribute__((ext_vector_type(4)));
__device__ __forceinline__ void kload8(bf16x8*kf,lds_cptr kp){
  kf[0]=*(const __attribute__((address_space(3))) bf16x8*)(kp);      kf[1]=*(const __attribute__((address_space(3))) bf16x8*)(kp+512);
  kf[2]=*(const __attribute__((address_space(3))) bf16x8*)(kp+2048); kf[3]=*(const __attribute__((address_space(3))) bf16x8*)(kp+2560);
  kf[4]=*(const __attribute__((address_space(3))) bf16x8*)(kp+4096); kf[5]=*(const __attribute__((address_space(3))) bf16x8*)(kp+4608);
  kf[6]=*(const __attribute__((address_space(3))) bf16x8*)(kp+6144); kf[7]=*(const __attribute__((address_space(3))) bf16x8*)(kp+6656);
}
__device__ __forceinline__ void kload2(bf16x8*kf,lds_cptr kp,int j){ kf[2*j]=*(const __attribute__((address_space(3))) bf16x8*)(kp+j*2048); kf[2*j+1]=*(const __attribute__((address_space(3))) bf16x8*)(kp+j*2048+512); }
__device__ __forceinline__ s16x4 vtr(lds_cptr p){ return __builtin_bit_cast(s16x4,__builtin_amdgcn_ds_read_tr16_b64_v4i16((__attribute__((address_space(3))) v4i16_t*)p)); }
__device__ __forceinline__ float rowmax(const f32x16&p0,const f32x16&p1){
  float a=max3f(p0[0],p0[1],p1[0]),b=max3f(p0[2],p0[3],p1[1]);a=max3f(a,p1[2],p1[3]);
  #pragma unroll
  for(int r=4;r<16;r+=4){a=max3f(a,p0[r],p0[r+1]);b=max3f(b,p0[r+2],p0[r+3]);a=max3f(a,p1[r],p1[r+1]);b=max3f(b,p1[r+2],p1[r+3]);}
  const float m=max2f(a,b);
  auto rr=__builtin_amdgcn_permlane32_swap(__float_as_uint(m),__float_as_uint(m),false,false);
  return max2f(__uint_as_float(rr[0]),__uint_as_float(rr[1]));
}
__device__ __forceinline__ void pv(f32x16*o,int vb,bf16x8 pa0,bf16x8 pa1,bf16x8 pa2,bf16x8 pa3){
  #pragma unroll
  for(int d0=0;d0<4;++d0){s16x4 lo[4],hi[4];
    #pragma unroll
    for(int ks=0;ks<4;++ks){
      asm volatile("ds_read_b64_tr_b16 %0,%1 offset:%c2":"=&v"(lo[ks]):"v"(vb),"i"(d0*4096+ks*1024):"memory");
      asm volatile("ds_read_b64_tr_b16 %0,%1 offset:%c2":"=&v"(hi[ks]):"v"(vb),"i"(d0*4096+ks*1024+512):"memory");}
    asm volatile("s_waitcnt lgkmcnt(0)":::"memory");SBAR();
    #define PK(k) (bf16x8){lo[k][0],lo[k][1],lo[k][2],lo[k][3],hi[k][0],hi[k][1],hi[k][2],hi[k][3]}
    o[d0]=__builtin_amdgcn_mfma_f32_32x32x16_bf16(pa0,PK(0),o[d0],0,0,0);
    o[d0]=__builtin_amdgcn_mfma_f32_32x32x16_bf16(pa1,PK(1),o[d0],0,0,0);
    o[d0]=__builtin_amdgcn_mfma_f32_32x32x16_bf16(pa2,PK(2),o[d0],0,0,0);
    o[d0]=__builtin_amdgcn_mfma_f32_32x32x16_bf16(pa3,PK(3),o[d0],0,0,0);
    #undef PK
  }
}

template<int THRL> __device__ __forceinline__ void attn_unit(int b,int qc,int kc,int vc,int oc,int qb,const bf16*Q,const bf16*__restrict__ K,const bf16*__restrict__ V,bf16*O,char*shm,const int wid){
  const int lane=(int)__builtin_amdgcn_mbcnt_hi(~0u,__builtin_amdgcn_mbcnt_lo(~0u,0u)),r32=lane&31,hi=lane>>5;
  const long rowbase=(long)b*SEQ; const int q0=qb*QB;
  const bf16*Qw=Q+(rowbase+q0+wid*QBLK)*QP+qc;
  const bf16*Kh=K+rowbase*KP+kc,*Vh=V+rowbase*VP+vc;
  const unsigned lds0=(unsigned)(uintptr_t)shm;
  float*wsf=(float*)(shm+LDS_WS)+wid*64;
  const bf16*ksrc=Kh+wid*8; const unsigned koff=(unsigned)(lane*KP*2);
  const bf16*vsrc=Vh+(long)(16*(wid&3))*VP+(wid>>2)*32; const unsigned voff=(unsigned)(((lane>>2)*VP+(lane&3)*8)*2);
  const unsigned kdst=lds0+LDS_K+wid*1024, vdst=lds0+LDS_V+wid*1024;
  #define DMA_K(t,slot) glds16(ksrc+(long)(t)*KVBLK*KP,koff,(unsigned)__builtin_amdgcn_readfirstlane(kdst+(slot)))
  #define DMA_V(t,slot) do{ glds16(vsrc+(long)(t)*KVBLK*VP,voff,(unsigned)__builtin_amdgcn_readfirstlane(vdst+2*(slot))); glds16(vsrc+(long)(t)*KVBLK*VP+64,voff,(unsigned)__builtin_amdgcn_readfirstlane(vdst+2*(slot)+8192)); }while(0)
  const int vb0=(int)(lds0+LDS_V)+((lane>>4)&1)*32+(lane&3)*8+(4*hi+((lane&15)>>2))*64;
  const char*Kbase=shm+LDS_K; bf16x8 kf[8];
  const lds_cptr shm3=(lds_cptr)shm; const lds_cptr kp0=shm3+LDS_K+hi*1024+r32*16; const lds_cptr vp0=shm3+LDS_V+((lane>>4)&1)*32+(lane&3)*8+(4*hi+((lane&15)>>2))*64;
  const int NT=(q0+QB)/KVBLK;
  DMA_K(0,0);DMA_V(0,0);DMA_K(1,SLOTB);
  bf16x8 qr[4];
  #pragma unroll
  for(int d0=0;d0<4;++d0)qr[d0]=*reinterpret_cast<const bf16x8*>(&Qw[(long)r32*QP+d0*16+hi*8]);
  float mhat=0.f,l_reg=0.f;f32x16 o[4];o[0]=f32x16{};o[1]=f32x16{};o[2]=f32x16{};o[3]=f32x16{};const f32x16 zz=f32x16{};
  const int qrel=wid*QBLK+r32;
  #define CMASK(P0,P1,t) do{int jb_=(t)-(NT-4); if(jb_>=0)cmask(P0,P1,jb_,qrel,hi);}while(0)
  bool resc=false;
  #define START(P0,P1) do{ const float rm=rowmax(P0,P1); resc=false; mhat=rm; \
    _Pragma("unroll") for(int r=0;r<16;++r)P0[r]=__builtin_amdgcn_exp2f(fsub_s(P0[r],mhat)); }while(0)
  #define RESC() do{ if(resc){ asm volatile("s_waitcnt lgkmcnt(0)":::"memory"); \
      _Pragma("unroll") for(int d_=0;d_<4;++d_) _Pragma("unroll") for(int r=0;r<16;++r)o[d_][r]*=wsf[crow(r,hi)]; } }while(0)
  f32x16 pA0,pA1,pB0,pB1;
  int sl_prev=0,sl_cur=0,sl_next=SLOTB;
  #define ROT() do{sl_prev=sl_cur;sl_cur=sl_next;sl_next=(sl_next==(NSLOT-1)*SLOTB)?0:sl_next+SLOTB;}while(0)
  DMA_K(2,2*SLOTB);
  WAIT_BAR(4);
  qkt(pA0,pA1,Kbase,qr,r32,hi);asm volatile("s_nop 15\n\ts_nop 7":"+v"(pA0),"+v"(pA1));CMASK(pA0,pA1,0);
  START(pA0,pA1);
  _Pragma("unroll") for(int r=0;r<16;++r)pA1[r]=__builtin_amdgcn_exp2f(fsub_s(pA1[r],mhat));
  WAIT_BAR(0);
  DMA_K(3,0);DMA_V(1,SLOTB);
  ROT();
  kload8(kf,kp0+sl_cur);
  WAIT_BAR(3);
  s16x4 vlo[6],vhi[6]; u32x4 pw0,pw1,pw2,pw3;
  #define PKW(P,B) cvtpk_s(P[B],P[B+1])
  #define PAF(k) __builtin_bit_cast(bf16x8,pw##k)
  #define VFR(i) (bf16x8){vlo[i][0],vlo[i][1],vlo[i][2],vlo[i][3],vhi[i][0],vhi[i][1],vhi[i][2],vhi[i][3]}
  #define PIN(x) asm volatile("":"+v"(x))
  #define MX3(a,b,c) __builtin_fmaxf(__builtin_fmaxf((a),(b)),(c))
  #define GAPA(MF,A0,A1,A2,A3,W0,W1,PW) do{ MF; sacc+=A0; sacc+=A1; sacc+=A2; sacc+=A3; PIN(sacc); W0; W1; PIN(PW); SBAR(); }while(0)
  #define EX(v) __builtin_amdgcn_exp2f((v)-mhat)
  #define GAPB(MF,X,B) do{ MF; X[B]=EX(X[B]); X[B+1]=EX(X[B+1]); PIN(X); SBAR(); }while(0)
  #define VRD(w,db,ks) do{ vlo[w]=vtr(vp_+((db)*4096+(ks)*1024)); vhi[w]=vtr(vp_+((db)*4096+(ks)*1024+512)); }while(0)
  #define VRD2(G,w,db,ks) do{ if(G){ VRD(w,db,ks); SBAR(); } }while(0)
  #define KRD(G,j) do{ if(G){ kload2(kf,kp0+sl_next,j); SBAR(); } }while(0)
  #define STEP(C0,C1,P0,P1,t,GK,GV,GL) do{ SBAR(); \
    const lds_cptr vp_=vp0+2*sl_prev; \
    VRD(0,0,0); SBAR(); float sacc=(P0[0]+P0[1]); \
    GAPA(C0=__builtin_amdgcn_mfma_f32_32x32x16_bf16(kf[0],qr[0],zz,0,0,0), P0[2],P0[3],P0[4],P0[5],     pw0[0]=PKW(P0,0), pw0[1]=PKW(P0,2), pw0); \
    VRD(1,1,0); SBAR(); GAPA(C1=__builtin_amdgcn_mfma_f32_32x32x16_bf16(kf[1],qr[0],zz,0,0,0), P0[6],P0[7],P0[8],P0[9],     pw0[2]=PKW(P0,4), pw0[3]=PKW(P0,6), pw0); \
    VRD(2,2,0); SBAR(); GAPA(C0=__builtin_amdgcn_mfma_f32_32x32x16_bf16(kf[2],qr[1],C0,0,0,0),   P0[10],P0[11],P0[12],P0[13], pw1[0]=PKW(P0,8), pw1[1]=PKW(P0,10), pw1); \
    VRD(3,3,0); SBAR(); GAPA(C1=__builtin_amdgcn_mfma_f32_32x32x16_bf16(kf[3],qr[1],C1,0,0,0),   P0[14],P0[15],P1[0],P1[1],   pw1[2]=PKW(P0,12),pw1[3]=PKW(P0,14), pw1); \
    VRD(4,0,1); SBAR(); GAPA(C0=__builtin_amdgcn_mfma_f32_32x32x16_bf16(kf[4],qr[2],C0,0,0,0),   P1[2],P1[3],P1[4],P1[5],     pw2[0]=PKW(P1,0), pw2[1]=PKW(P1,2), pw2); \
    VRD(5,1,1); SBAR(); GAPA(C1=__builtin_amdgcn_mfma_f32_32x32x16_bf16(kf[5],qr[2],C1,0,0,0),   P1[6],P1[7],P1[8],P1[9],     pw2[2]=PKW(P1,4), pw2[3]=PKW(P1,6), pw2); \
    GAPA(C0=__builtin_amdgcn_mfma_f32_32x32x16_bf16(kf[6],qr[3],C0,0,0,0),   P1[10],P1[11],P1[12],P1[13], pw3[0]=PKW(P1,8), pw3[1]=PKW(P1,10), pw3); \
    GAPA(C1=__builtin_amdgcn_mfma_f32_32x32x16_bf16(kf[7],qr[3],C1,0,0,0),   P1[14],P1[15],0.f,0.f,       pw3[2]=PKW(P1,12),pw3[3]=PKW(P1,14), pw3); \
    l_reg+=sacc; \
    if(GK){DMA_K((t)+3,sl_cur);} if(GV){DMA_V((t)+1,sl_next);} \
    CMASK(C0,C1,t); \
    { float a=MX3(C0[0],C0[1],C1[0]),b=MX3(C0[2],C0[3],C1[1]); a=MX3(a,C1[2],C1[3]); \
      _Pragma("unroll") for(int r=4;r<16;r+=4){a=MX3(a,C0[r],C0[r+1]);b=MX3(b,C0[r+2],C0[r+3]);a=MX3(a,C1[r],C1[r+1]);b=MX3(b,C1[r+2],C1[r+3]);} \
      float rm=__builtin_fmaxf(a,b); { auto rr=__builtin_amdgcn_permlane32_swap(__float_as_uint(rm),__float_as_uint(rm),false,false); rm=__builtin_fmaxf(__uint_as_float(rr[0]),__uint_as_float(rr[1])); } \
      resc=false; rm-=mhat; \
      if(__builtin_expect(__any(rm>(float)THRL),0)){ const float dl=__builtin_fmaxf(rm,0.f); mhat+=dl; \
        const float f=__builtin_amdgcn_exp2f(-dl); l_reg*=f; if(hi==0)wsf[r32]=f; resc=true; } } \
    SBAR(); \
    GAPB(o[0]=__builtin_amdgcn_mfma_f32_32x32x16_bf16(PAF(0),VFR(0),o[0],0,0,0), C0,0); VRD2(true,0,2,1); \
    GAPB(o[1]=__builtin_amdgcn_mfma_f32_32x32x16_bf16(PAF(0),VFR(1),o[1],0,0,0), C0,2); VRD2(true,1,3,1); \
    GAPB(o[2]=__builtin_amdgcn_mfma_f32_32x32x16_bf16(PAF(0),VFR(2),o[2],0,0,0), C0,4); VRD2(true,2,0,2); \
    GAPB(o[3]=__builtin_amdgcn_mfma_f32_32x32x16_bf16(PAF(0),VFR(3),o[3],0,0,0), C0,6); VRD2(true,3,1,2); \
    GAPB(o[0]=__builtin_amdgcn_mfma_f32_32x32x16_bf16(PAF(1),VFR(4),o[0],0,0,0), C0,8); VRD2(true,4,2,2); \
    GAPB(o[1]=__builtin_amdgcn_mfma_f32_32x32x16_bf16(PAF(1),VFR(5),o[1],0,0,0), C0,10); VRD2(true,5,3,2); \
    GAPB(o[2]=__builtin_amdgcn_mfma_f32_32x32x16_bf16(PAF(1),VFR(0),o[2],0,0,0), C0,12); VRD2(true,0,0,3); \
    GAPB(o[3]=__builtin_amdgcn_mfma_f32_32x32x16_bf16(PAF(1),VFR(1),o[3],0,0,0), C0,14); VRD2(true,1,1,3); \
    GAPB(o[0]=__builtin_amdgcn_mfma_f32_32x32x16_bf16(PAF(2),VFR(2),o[0],0,0,0), C1,0); VRD2(true,2,2,3); \
    GAPB(o[1]=__builtin_amdgcn_mfma_f32_32x32x16_bf16(PAF(2),VFR(3),o[1],0,0,0), C1,2); VRD2(true,3,3,3); \
    KRD(GL,0); GAPB(o[2]=__builtin_amdgcn_mfma_f32_32x32x16_bf16(PAF(2),VFR(4),o[2],0,0,0), C1,4); \
    KRD(GL,1); GAPB(o[3]=__builtin_amdgcn_mfma_f32_32x32x16_bf16(PAF(2),VFR(5),o[3],0,0,0), C1,6); \
    KRD(GL,2); GAPB(o[0]=__builtin_amdgcn_mfma_f32_32x32x16_bf16(PAF(3),VFR(0),o[0],0,0,0), C1,8); \
    KRD(GL,3); GAPB(o[1]=__builtin_amdgcn_mfma_f32_32x32x16_bf16(PAF(3),VFR(1),o[1],0,0,0), C1,10); \
    GAPB(o[2]=__builtin_amdgcn_mfma_f32_32x32x16_bf16(PAF(3),VFR(2),o[2],0,0,0), C1,12); \
    GAPB(o[3]=__builtin_amdgcn_mfma_f32_32x32x16_bf16(PAF(3),VFR(3),o[3],0,0,0), C1,14); \
    }while(0)
  if(wid>=4)__builtin_amdgcn_s_setprio(1);
  int t=1;
  #undef CMASK
  #define CMASK(P0,P1,t) do{}while(0)
  for(;t+5<NT;t+=2){
    STEP(pB0,pB1,pA0,pA1,t,true,true,true);     WAIT_BAR(3); RESC(); ROT();
    STEP(pA0,pA1,pB0,pB1,t+1,true,true,true);   WAIT_BAR(3); RESC(); ROT();
  }
  #undef CMASK
  #define CMASK(P0,P1,t) do{int jb_=(t)-(NT-4); if(jb_>=0)cmask(P0,P1,jb_,qrel,hi);}while(0)
  #define ENDW(tt) do{ if((tt)+3<NT){WAIT_BAR(3);} else if((tt)+2<NT){WAIT_BAR(2);} else {WAIT_BAR(0);} }while(0)
  for(;t+1<NT;t+=2){
    STEP(pB0,pB1,pA0,pA1,t,(t+3<NT),(t+1<NT),(t+1<NT));       ENDW(t);   RESC(); ROT();
    STEP(pA0,pA1,pB0,pB1,t+1,(t+4<NT),(t+2<NT),(t+2<NT));     ENDW(t+1); RESC(); ROT();
  }
  STEP(pB0,pB1,pA0,pA1,NT-1,false,false,false); RESC();
  { float sacc=pB0[0]+pB0[1]; _Pragma("unroll") for(int r=2;r<16;++r)sacc+=pB0[r]; _Pragma("unroll") for(int r=0;r<16;++r)sacc+=pB1[r]; l_reg+=sacc;
    pw0=(u32x4){PKW(pB0,0),PKW(pB0,2),PKW(pB0,4),PKW(pB0,6)};pw1=(u32x4){PKW(pB0,8),PKW(pB0,10),PKW(pB0,12),PKW(pB0,14)};pw2=(u32x4){PKW(pB1,0),PKW(pB1,2),PKW(pB1,4),PKW(pB1,6)};pw3=(u32x4){PKW(pB1,8),PKW(pB1,10),PKW(pB1,12),PKW(pB1,14)};
    SBAR(); pv(o,vb0+2*sl_cur,PAF(0),PAF(1),PAF(2),PAF(3)); }
  #undef PKW
  #undef PAF
  #undef VFR
  #undef PIN
  #undef MX3
  #undef GAPA
  #undef GAPB
  #undef EX
  #undef VRD
  #undef KRD
  #undef VRD2
  #undef STEP
  #undef ENDW
  {auto rr=__builtin_amdgcn_permlane32_swap(__float_as_uint(l_reg),__float_as_uint(l_reg),false,false);l_reg=__uint_as_float(rr[0])+__uint_as_float(rr[1]);}
  if(hi==0)wsf[32+r32]=l_reg;asm volatile("s_waitcnt lgkmcnt(0)":::"memory");
  float rli[16];
  #pragma unroll
  for(int r=0;r<16;++r)rli[r]=__builtin_amdgcn_rcpf(wsf[32+crow(r,hi)]);
  bf16*Ow=O+(rowbase+q0+wid*QBLK)*OP+oc;
  { bf16*stg=(bf16*)(shm+LDS_OST)+wid*2048;
    #pragma unroll
    for(int dh=0;dh<2;++dh){
      #pragma unroll
      for(int r=0;r<16;++r){const int orow=crow(r,hi);
        #pragma unroll
        for(int d0=0;d0<2;++d0)stg[orow*64+d0*32+r32]=__float2bfloat16(o[2*dh+d0][r]*rli[r]);}
      asm volatile("s_waitcnt lgkmcnt(0)":::"memory");
      #pragma unroll
      for(int i=0;i<4;++i){const int row=i*8+(lane>>3),ch=lane&7; const u32x4 v=*(const u32x4*)(stg+row*64+ch*8); ATTN_STORE16(Ow+(long)row*OP+dh*64+ch*8,v);}
      asm volatile("s_waitcnt lgkmcnt(0)":::"memory"); } }
  __builtin_amdgcn_s_setprio(0);
  asm volatile("s_waitcnt lgkmcnt(0)\n\ts_barrier":::"memory");
  #undef DMA_K
  #undef DMA_V
  #undef CMASK
  #undef START
  #undef RESC
  #undef ROT
}
constexpr int ATTN_LDS_BYTES=LDS_BYTES;
struct AttnTensors { const bf16* Q; const bf16* K; const bf16* V; bf16* O; };
struct AttnUnit { int b, hm, qb; };
struct SlotOrder {
  int vcu, G;
  __device__ __forceinline__ SlotOrder(int grid,int block):vcu((grid%8==0)?(block%8)*(grid/8)+block/8:block),G(grid){}
  __device__ __forceinline__ bool next(int i,AttnUnit&u)const{ const int sl=vcu+(i>>2)*G; if(sl>=256)return false; const int x=sl>>5,h=(sl&31)>>3,s=8*(x&1)+(sl&7),k=i&3;
    u.b=x>>1; u.hm=2*h+(k&1); u.qb=(k<2)?s:31-s; return true; }
};
template<class Sched,class Hook,class Comb,int THRL=8> __device__ __forceinline__ void attn_phase(char*lds,const AttnTensors&T,const Sched&S,const Hook&H,const Comb&C,const int wid){
  AttnUnit u; int i=0;
  for(;S.next(i,u);++i){ const int h=u.hm>>1,m=u.hm&1; attn_unit<THRL>(u.b,u.hm*64,u.hm*64,h*128,m*512+h*128,u.qb,T.Q,T.K,T.V,T.O,lds,wid);
    if(i<4){ H(i); asm volatile("s_waitcnt lgkmcnt(0)\n\ts_barrier":::"memory"); } }
  const int nu=i;
  for(;i<4;++i){ H(i); asm volatile("s_waitcnt lgkmcnt(0)\n\ts_barrier":::"memory"); }
  asm volatile("s_waitcnt vmcnt(0)":::"memory");
  for(int j=0;j<nu;j+=2){ AttnUnit v; S.next(j,v); C(v,wid); }
}
}
__device__ __forceinline__ int lane_opaque() { int l = (int)__builtin_amdgcn_mbcnt_hi(~0u, __builtin_amdgcn_mbcnt_lo(~0u, 0u)); asm volatile("" : "+v"(l)); return l; }
struct Args { const float* in[24]; float* out; unsigned char* ws; double invf[32]; };
typedef const __attribute__((address_space(4))) Args* KArgsP;
__device__ __forceinline__ KArgsP kargs() { unsigned long long p = (unsigned long long)__builtin_amdgcn_kernarg_segment_ptr(); asm volatile("" : "+s"(p)); return (KArgsP)p; }
struct ExpertCvt {
    int gw, NGW, wid; LAS unsigned char* L;
    __device__ __forceinline__ void operator()(int c) const {
        KArgsP KA = kargs(); const float* w_eg = KA->in[19]; const float* w_eu = KA->in[20]; const float* w_ed = KA->in[21];
        bf16* WguT = (bf16*)(KA->ws + WS_WGU); bf16* WdT = (bf16*)(KA->ws + WS_WD); LAS float* scr = (LAS float*)(L + RING_OFF + wid * 16384);
        constexpr int I_EG = NE * (D / 64) * (FF / 32), I_ED = NE * (FF / 64) * (D / 32), NIT = 2 * I_EG + I_ED;
        int lane_ = (int)__builtin_amdgcn_mbcnt_hi(~0u, __builtin_amdgcn_mbcnt_lo(~0u, 0u)); asm volatile("" : "+v"(lane_)); const int lane = lane_;
        const int kmax = (NIT + NGW - 1) / NGW, kc = (kmax + 3) / 4;
        for (int k = c * kc; k < (c + 1) * kc && k < kmax; ++k) { int r = gw + k * NGW; if (r >= NIT) break;
            if (r < 2 * I_EG) { const int up = r >= I_EG; if (up) r -= I_EG; const int per = (D / 64) * (FF / 32), e = r / per, q = r % per, nblk = FF / 32, kb = q / nblk, nb = q % nblk, n0 = 32 * nb;
                transpose_item<false>((up ? w_eu : w_eg) + (size_t)e * D * FF, D, FF, WguT, 64 * kb, n0, e * 1024 + (n0 >> 7) * 256 + up * 128 + (n0 & 127), scr, lane); }
            else { r -= 2 * I_EG; const int per = (FF / 64) * (D / 32), e = r / per, q = r % per, nblk = D / 32, kb = q / nblk, nb = q % nblk;
                transpose_item<false>(w_ed + (size_t)e * FF * D, FF, D, WdT, 64 * kb, 32 * nb, e * 1024 + 32 * nb, scr, lane); } }
    }
};

struct CombineOwn {
    __device__ __forceinline__ void operator()(const attn_b::AttnUnit& u, int wid) const {
        KArgsP KA = kargs(); int lane_ = (int)__builtin_amdgcn_mbcnt_hi(~0u, __builtin_amdgcn_mbcnt_lo(~0u, 0u)); asm volatile("" : "+v"(lane_)); const int lane = lane_;
        const float* q1 = KA->in[4]; const float* k1 = KA->in[5]; const float* q2 = KA->in[6]; const float* k2 = KA->in[7]; const float* sgp = KA->in[8];
        float lam; { const float p1 = q1[lane] * k1[lane], p2 = q2[lane] * k2[lane]; lam = expf(wave_sum(p1)) - expf(wave_sum(p2)) + LAMBDA_INIT; }
        float sg[8];
#pragma unroll
        for (int e = 0; e < 8; ++e) sg[e] = sgp[(lane & 15) * 8 + e] * (1.f - LAMBDA_INIT);
        const int h = u.hm >> 1; const size_t t0 = (size_t)u.b * SEQ + (size_t)u.qb * 256 + wid * 32 + (lane >> 4);
        const bf16* O = (const bf16*)KA->out + h * 128 + (lane & 15) * 8; bf16* OB = (bf16*)KA->out + (size_t)T * 1024 + 512 + h * 128 + (lane & 15) * 8;
        v4u a[8], bb[8];
#pragma unroll
        for (int r = 0; r < 8; ++r) { const size_t t = t0 + r * 4; a[r] = *(const v4u*)(O + t * 1024); bb[r] = *(const v4u*)(O + t * 1024 + 512); }
#pragma unroll
        for (int r = 0; r < 8; ++r) { const size_t t = t0 + r * 4; float v[8]; float ss = 0.f;
#pragma unroll
            for (int e = 0; e < 4; ++e) { v[2 * e] = bflo(a[r][e]) - lam * bflo(bb[r][e]); v[2 * e + 1] = bfhi(a[r][e]) - lam * bfhi(bb[r][e]); ss += v[2 * e] * v[2 * e] + v[2 * e + 1] * v[2 * e + 1]; }
            ss += __shfl_xor(ss, 1); ss += __shfl_xor(ss, 2); ss += __shfl_xor(ss, 4); ss += __shfl_xor(ss, 8);
            const float rs = 1.f / sqrtf(ss * (1.f / 128.f) + SUBLN_EPS); v4u o;
#pragma unroll
            for (int e = 0; e < 4; ++e) o[e] = pk2(v[2 * e] * rs * sg[2 * e], v[2 * e + 1] * rs * sg[2 * e + 1]);
            *(v4u*)(OB + t * 1024) = o; }
    }
};

__global__ void __launch_bounds__(NWAVES * 64, 2) fwd(Args) {
    extern __shared__ __attribute__((aligned(16))) unsigned char lds[];
    LAS unsigned char* L = (LAS unsigned char*)lds;
    KArgsP KA = kargs();
    volatile LAS unsigned* MISC = (volatile LAS unsigned*)(L + MISC_OFF);
    const int tid = threadIdx.x, wave0 = __builtin_amdgcn_readfirstlane(tid >> 6);
    const int G0 = gridDim.x;
    const int vcu0 = (G0 % 8 == 0) ? ((int)blockIdx.x % 8) * (G0 / 8) + (int)blockIdx.x / 8 : (int)blockIdx.x;
    for (int u = tid; u < (LDS_BYTES - LDSCTL_OFF) / 4; u += NWAVES * 64) ((LAS unsigned*)(L + LDSCTL_OFF))[u] = 0u;
    __syncthreads();
    XcdBarrier bar = xcd_barrier_post((unsigned*)((gu32*)(KA->ws + WS_CTL) + CW_BAR), MISC + 8);
#define GRID_BAR() xcd_barrier(bar)
#define COUNT_BAR(word) do { asm volatile("s_waitcnt vmcnt(0)" ::: "memory"); __syncthreads(); \
        if (threadIdx.x == 0) { unsigned* cw_ = (unsigned*)(kargs()->ws + WS_CTL) + (word); (void)__hip_atomic_fetch_add(cw_, 1u, RLX_AGENT); unsigned sp_ = 0; \
            while (__hip_atomic_load(cw_, RLX_AGENT) < gridDim.x && ++sp_ < (1u << 26)) __builtin_amdgcn_s_sleep(1); \
            __builtin_amdgcn_fence(__ATOMIC_ACQUIRE, "agent"); asm volatile("s_waitcnt vmcnt(0)" ::: "memory"); } \
        __syncthreads(); } while (0)
#define PAIR_BAR() do { if (__builtin_amdgcn_readfirstlane(bar.st[2]) == 0u) xcd_barrier_pair(bar); else xcd_barrier(bar); } while (0)
#define LOCAL_BAR() do { if (__builtin_amdgcn_readfirstlane(bar.st[2]) == 0u) xcd_barrier_local(bar); else xcd_barrier(bar); } while (0)
#define LOCAL_BAR_REL() do { if (__builtin_amdgcn_readfirstlane(bar.st[2]) == 0u) xcd_barrier_local<true>(bar); else xcd_barrier(bar); } while (0)

#define XIN ((const float*)KA->in[0])
#define positions ((const int*)KA->in[1])
#define w_in (KA->in[2])
#define b_gate (KA->in[3])
#define lq1 (KA->in[4])
#define lk1 (KA->in[5])
#define lq2 (KA->in[6])
#define lk2 (KA->in[7])
#define subln_g (KA->in[8])
#define w_o_att (KA->in[9])
#define conv_w (KA->in[10])
#define w_o_conv (KA->in[11])
#define w_mix (KA->in[12])
#define ln1_g (KA->in[13])
#define ln1_b (KA->in[14])
#define w_rg (KA->in[15])
#define b_rg (KA->in[16])
#define w_re (KA->in[17])
#define b_re (KA->in[18])
#define w_eg (KA->in[19])
#define w_eu (KA->in[20])
#define w_ed (KA->in[21])
#define ln2_g (KA->in[22])
#define ln2_b (KA->in[23])
#define out (KA->out)
#define ROPE ((float2*)(KA->ws + WS_ROPE))
#define LIST ((int2*)(KA->ws + WS_LIST))
#define WRT ((float*)(KA->ws + WS_WRT))
#define WinT ((bf16*)(KA->ws + WS_WIN))
#define WcatT ((bf16*)(KA->ws + WS_WOA))
#define WmixT ((bf16*)(KA->ws + WS_WMIX))
#define WguT ((bf16*)(KA->ws + WS_WGU))
#define WdT ((bf16*)(KA->ws + WS_WD))
#define XB ((bf16*)(KA->ws + WS_XB))
#define OR ((bf16*)out)
#define YS ((bf16*)(KA->ws + WS_YS))
#define QB ((bf16*)(KA->ws + WS_Q))
#define KB ((bf16*)(KA->ws + WS_K))
#define VB ((bf16*)(KA->ws + WS_V))
#define MG ((bf16*)(KA->ws + WS_MG))
#define H1B ((bf16*)(KA->ws + WS_H1B))
#define CB ((bf16*)(KA->ws + WS_CB))
#define UB ((bf16*)(KA->ws + WS_U))
#define OBF ((bf16*)out + (size_t)T * 1024)
#define HM ((bf16*)(KA->ws + WS_HM))
#define GB ((bf16*)(KA->ws + WS_G))
#define CNT ((gu32*)(KA->ws + WS_CTL) + CW_CNT)
#define RDY ((unsigned*)(KA->ws + WS_CTL) + CW_RDY)

    KA = kargs();
    { int wave = wave0, G = G0, vcu = vcu0, bidx = (int)blockIdx.x; asm volatile("" : "+s"(wave), "+s"(G), "+s"(vcu), "+s"(bidx));
      const int gw = vcu * NWAVES + wave, NGW = G * NWAVES, NGT = NGW * 64; (void)gw; (void)NGW; (void)NGT; (void)bidx;
    {
        const int lane = lane_opaque(), gt = gw * 64 + lane; (void)gt;
        LAS float* scr = (LAS float*)(L + RING_OFF + wave * 16384);
        constexpr int I_IN = (D / 64) * (NPROJ / 32), I_OA = (512 / 64) * (D / 32), I_MIX = (D / 64) * (D / 32);
        constexpr int I_EG = NE * (D / 64) * (FF / 32), I_ED = NE * (FF / 64) * (D / 32);
        constexpr int NITEMS = I_IN + 2 * I_OA + I_MIX;
        for (int it = gw; it < NITEMS; it += NGW) {
            int r = it;
            if (r < I_IN) { const int nblk = NPROJ / 32, kb = r / nblk, nb = r % nblk; transpose_item<true>(w_in, D, NPROJ, WinT, 64 * kb, 32 * nb, n_of(32 * nb), scr, lane); continue; } r -= I_IN;
            if (r < I_OA) { const int nblk = D / 32, kb = r / nblk, nb = r % nblk; transpose_item(w_o_att, 512, D, WcatT + 512, 64 * kb, 32 * nb, 32 * nb, scr, lane, 1024); continue; } r -= I_OA;
            if (r < I_OA) { const int nblk = D / 32, kb = r / nblk, nb = r % nblk; transpose_item(w_o_conv, 512, D, WcatT, 64 * kb, 32 * nb, 32 * nb, scr, lane, 1024); continue; } r -= I_OA;
            { const int nblk = D / 32, kb = r / nblk, nb = r % nblk; transpose_item(w_mix, D, D, WmixT, 64 * kb, 32 * nb, 32 * nb, scr, lane); }
        }
        asm volatile("s_waitcnt vmcnt(0)" ::: "memory"); __syncthreads();
        if (threadIdx.x == 0) (void)__hip_atomic_fetch_add((unsigned*)(KA->ws + WS_CTL) + CW_WDONE, 1u, RLX_AGENT);
        { const size_t XCH = (size_t)T * D / 4 / 8; const size_t nxt = (G % 8 == 0) ? (size_t)NGT / 8 : (size_t)NGT, xq = (G % 8 == 0) ? (size_t)gt / nxt : 0, xb0 = xq * XCH, xe = (G % 8 == 0) ? xb0 + XCH : (size_t)T * D / 4, tx = (G % 8 == 0) ? (size_t)gt % nxt : (size_t)gt;
        for (size_t i = xb0 + tx; i < xe; i += nxt * 16) { f32x4 v[16];
#pragma unroll
            for (int q = 0; q < 16; ++q) v[q] = (i + (size_t)q * nxt < xe) ? ((const f32x4*)XIN)[i + (size_t)q * nxt] : (f32x4){0.f, 0.f, 0.f, 0.f};
#pragma unroll
            for (int q = 0; q < 16; ++q) if (i + (size_t)q * nxt < xe) { v2u o; o.x = pk2(v[q].x, v[q].y); o.y = pk2(v[q].z, v[q].w); ((v2u*)XB)[i + (size_t)q * nxt] = o; } }
          const int RCH = T * 32 / 8, rb0 = (G % 8 == 0) ? (int)xq * RCH : 0, re = (G % 8 == 0) ? rb0 + RCH : T * 32;
          for (int i = rb0 + (int)tx; i < re; i += (int)nxt) { const int t = i >> 5, f = i & 31; const double ang = (double)positions[t] * KA->invf[f];
            const double k = rint(ang * 0.15915494309189535); double r = fma(-k, 6.283185307179586, ang); r = fma(-k, 2.4492935982947064e-16, r);
            const float rf = (float)r; ROPE[i] = make_float2(cosf(rf), sinf(rf)); } }
        for (int i = gt; i < 36 * D; i += NGT) { const int c = i >> 10, k = i & (D - 1); WRT[i] = c < 32 ? w_re[(size_t)k * 32 + c] : w_rg[(size_t)k * 4 + (c - 32)]; }
        if (threadIdx.x == 0) { unsigned sp = 0; while (__hip_atomic_load((unsigned*)(KA->ws + WS_CTL) + CW_WDONE, RLX_AGENT) < (unsigned)G && ++sp < (1u << 24)) __builtin_amdgcn_s_sleep(2); }
    }
    if (threadIdx.x == 0) { unsigned nloc, nx, bad; xcd_barrier_complete(bar.bar, bar.x, nloc, nx, bad); bar.st[0] = nloc; bar.st[1] = nx; bar.st[2] = bad; }
    __syncthreads();
    LOCAL_BAR();

    }
    KA = kargs();
    { int wave = wave0, G = G0, vcu = vcu0, bidx = (int)blockIdx.x; asm volatile("" : "+s"(wave), "+s"(G), "+s"(vcu), "+s"(bidx));
      const int gw = vcu * NWAVES + wave, NGW = G * NWAVES, NGT = NGW * 64; (void)gw; (void)NGW; (void)NGT; (void)bidx;
    {
        pg8::Gemm g{XB, WinT, T, NPROJ, D}; pg8::StaticOrder S; S.init(T, NPROJ, G, bidx);
        pg8::EpiProj E{QB, KB, VB, CB, UB, GB, (const float*)ROPE, b_gate, C2};
        pg8::gemm_phase<pg8::EpiProj, pg8::StaticOrder, true, true>(L + RING_OFF, g, S, E, wave);
    }
    PAIR_BAR();

    }
    KA = kargs();
    { int wave = wave0, G = G0, vcu = vcu0, bidx = (int)blockIdx.x; asm volatile("" : "+s"(wave), "+s"(G), "+s"(vcu), "+s"(bidx));
      const int gw = vcu * NWAVES + wave, NGW = G * NWAVES, NGT = NGW * 64; (void)gw; (void)NGW; (void)NGT; (void)bidx;
    { const int lane = lane_opaque(), gt = gw * 64 + lane;
    float cw[3][8];
    { const int c0 = (gt & 63) * 8;
#pragma unroll
      for (int k = 0; k < 3; ++k)
#pragma unroll
          for (int e = 0; e < 8; ++e) cw[k][e] = conv_w[k * 512 + c0 + e]; }
    const int XCH = T * 64 / 8, nxt = (G % 8 == 0) ? NGT / 8 : NGT, xbase = (G % 8 == 0) ? (gt / nxt) * XCH : 0, xend = (G % 8 == 0) ? xbase + XCH : T * 64, tx = (G % 8 == 0) ? gt % nxt : gt;
    for (int i0 = xbase + tx; i0 < xend; i0 += 4 * nxt) {
        v4u cbv[4], u2v[4], u1v[4], u0v[4];
#pragma unroll
        for (int q = 0; q < 4; ++q) { int i = i0 + q * nxt; i = i < xend ? i : xend - 1; const int ts = i >> 14, t = own_tile(ts) * 256 + ((i >> 6) & 255), c0 = (i & 63) * 8, s = t & (SEQ - 1);
            cbv[q] = *(const v4u*)(CB + (size_t)t * 512 + c0); u2v[q] = *(const v4u*)(UB + (size_t)t * 512 + c0);
            u1v[q] = *(const v4u*)(UB + (size_t)(t - (s >= 1 ? 1 : 0)) * 512 + c0);
            u0v[q] = *(const v4u*)(UB + (size_t)(t - (s >= 2 ? 2 : 0)) * 512 + c0); }
#pragma unroll
        for (int q = 0; q < 4; ++q) { const int i = i0 + q * nxt, ts = i >> 14, t = own_tile(ts) * 256 + ((i >> 6) & 255), c0 = (i & 63) * 8, s = t & (SEQ - 1); if (i >= xend) continue;
            const v4u cb = cbv[q], u2 = u2v[q]; v4u u1 = u1v[q], u0 = u0v[q]; v4u o;
            if (s < 1) u1 = (v4u){0u, 0u, 0u, 0u};
            if (s < 2) u0 = (v4u){0u, 0u, 0u, 0u};
#pragma unroll
            for (int j = 0; j < 4; ++j) {
                const float ylo = cw[0][2 * j] * bflo(u0[j]) + cw[1][2 * j] * bflo(u1[j]) + cw[2][2 * j] * bflo(u2[j]);
                const float yhi = cw[0][2 * j + 1] * bfhi(u0[j]) + cw[1][2 * j + 1] * bfhi(u1[j]) + cw[2][2 * j + 1] * bfhi(u2[j]);
                o[j] = pk2(bflo(cb[j]) * ylo, bfhi(cb[j]) * yhi); }
            *(v4u*)(OBF + (size_t)t * 1024 + c0) = o; } }
    __syncthreads(); if (threadIdx.x == 0) (void)__hip_atomic_fetch_add((unsigned*)(KA->ws + WS_CTL) + CW_P2DONE, 1u, RLX_AGENT); }

    }
    KA = kargs();
    { int wave = wave0, G = G0, vcu = vcu0, bidx = (int)blockIdx.x; asm volatile("" : "+s"(wave), "+s"(G), "+s"(vcu), "+s"(bidx));
      const int gw = vcu * NWAVES + wave, NGW = G * NWAVES, NGT = NGW * 64; (void)gw; (void)NGW; (void)NGT; (void)bidx;
    {
        const attn_b::AttnTensors AT{(const attn_b::bf16*)QB, (const attn_b::bf16*)KB, (const attn_b::bf16*)VB, (attn_b::bf16*)OR};
        const attn_b::SlotOrder S(G, bidx);
        const ExpertCvt H{gw, NGW, wave, L}; const CombineOwn C{};
        attn_b::attn_phase<attn_b::SlotOrder, ExpertCvt, CombineOwn>((char*)lds + RING_OFF, AT, S, H, C, wave);
    }
    LOCAL_BAR_REL();

    }
    KA = kargs();
    { int wave = wave0, G = G0, vcu = vcu0, bidx = (int)blockIdx.x; asm volatile("" : "+s"(wave), "+s"(G), "+s"(vcu), "+s"(bidx));
      const int gw = vcu * NWAVES + wave, NGW = G * NWAVES, NGT = NGW * 64; (void)gw; (void)NGW; (void)NGT; (void)bidx;
    {
        if (threadIdx.x == 0) { unsigned sp = 0; while (__hip_atomic_load((unsigned*)(KA->ws + WS_CTL) + CW_P2DONE, RLX_AGENT) < (unsigned)G && ++sp < (1u << 24)) __builtin_amdgcn_s_sleep(2); }
        __syncthreads();
        pg8::PlainSrc S; S.init(T, 1024, G, bidx);
        { pg8::Gemm g{OBF, WcatT, T, 1024, D}; pg8::EpiMerge E{MG, GB}; pg8::gemm_phase2<pg8::EpiMerge, pg8::PlainSrc>(L + RING_OFF, g, S, E, wave); }
    }
    LOCAL_BAR();

    }
    KA = kargs();
    { int wave = wave0, G = G0, vcu = vcu0, bidx = (int)blockIdx.x; asm volatile("" : "+s"(wave), "+s"(G), "+s"(vcu), "+s"(bidx));
      const int gw = vcu * NWAVES + wave, NGW = G * NWAVES, NGT = NGW * 64; (void)gw; (void)NGW; (void)NGT; (void)bidx;
    {
        pg8::PlainSrc S; S.init(T, 1024, G, bidx); S.rev = 1;
        pg8::Gemm g{MG, WmixT, T, 1024, D}; pg8::EpiResB E{XB, ALPHA}; pg8::gemm_phase2<pg8::EpiResB, pg8::PlainSrc>(L + RING_OFF, g, S, E, wave);
    }
    LOCAL_BAR();

    }
    KA = kargs();
    { int wave = wave0, G = G0, vcu = vcu0, bidx = (int)blockIdx.x; asm volatile("" : "+s"(wave), "+s"(G), "+s"(vcu), "+s"(bidx));
      const int gw = vcu * NWAVES + wave, NGW = G * NWAVES, NGT = NGW * 64; (void)gw; (void)NGW; (void)NGT; (void)bidx;
    {
        const int lane = lane_opaque(), tid7 = wave * 64 + lane;
        LAS float* HR = (LAS float*)(L + RING_OFF);
        LAS float* LG = (LAS float*)(L + LDSCTL_OFF + 2048);
        LAS int* CL = (LAS int*)(L + LDSCTL_OFF + 2048 + 4736);
        LAS int* RES = CL + 64;
        for (int blk = vcu; blk < T / 128; blk += G) {
            const int row0 = own_tile(blk >> 1) * 256 + (blk & 1) * 128;
            if (tid7 < 32) CL[tid7] = 0;
            f32x4 wE[16], wG[16];
            { const float* wep = WRT + (size_t)(lane & 31) * D + wave * 128 + 4 * (lane >> 5); const float* wgp = WRT + (size_t)(32 + (lane & 3)) * D + wave * 128 + 4 * (lane >> 5);
#pragma unroll
              for (int j = 0; j < 16; ++j) { wE[j] = *(const f32x4*)(wep + 8 * j); wG[j] = *(const f32x4*)(wgp + 8 * j); } }
            for (int sb = 0; sb < 4; ++sb) {
                v4u pw[4][2];
#pragma unroll
                for (int rr = 0; rr < 4; ++rr)
#pragma unroll
                    for (int j = 0; j < 2; ++j) pw[rr][j] = *(const v4u*)(XB + (size_t)(row0 + sb * 32 + wave * 4 + rr) * D + 8 * lane + 512 * j);
#pragma unroll
                for (int rr = 0; rr < 4; ++rr) { const int rl = wave * 4 + rr, t = row0 + sb * 32 + rl;
                    f32x4 v[4]; float sm = 0.f;
#pragma unroll
                    for (int j = 0; j < 2; ++j) { const v4u w = pw[rr][j];
                        v[2 * j] = (f32x4){bflo(w.x), bfhi(w.x), bflo(w.y), bfhi(w.y)}; v[2 * j + 1] = (f32x4){bflo(w.z), bfhi(w.z), bflo(w.w), bfhi(w.w)}; }
#pragma unroll
                    for (int j = 0; j < 4; ++j) sm += (v[j].x + v[j].y) + (v[j].z + v[j].w);
                    const float mean = wave_sum(sm) * (1.f / D); float s2 = 0.f;
#pragma unroll
                    for (int j = 0; j < 4; ++j) { v[j] = v[j] - mean; s2 += (v[j].x * v[j].x + v[j].y * v[j].y) + (v[j].z * v[j].z + v[j].w * v[j].w); }
                    const float rstd = 1.f / sqrtf(wave_sum(s2) * (1.f / D) + LN_EPS);
#pragma unroll
                    for (int j = 0; j < 2; ++j) { const int c0 = 8 * lane + 512 * j;
#pragma unroll
                        for (int q = 0; q < 2; ++q) { const f32x4 gg = *(const f32x4*)(ln1_g + c0 + 4 * q), bb = *(const f32x4*)(ln1_b + c0 + 4 * q);
                            v[2 * j + q] = v[2 * j + q] * rstd * gg + bb; *(LAS f32x4*)(HR + rl * 1028 + c0 + 4 * q) = v[2 * j + q]; }
                        v4u o; o.x = pk2(v[2 * j].x, v[2 * j].y); o.y = pk2(v[2 * j].z, v[2 * j].w); o.z = pk2(v[2 * j + 1].x, v[2 * j + 1].y); o.w = pk2(v[2 * j + 1].z, v[2 * j + 1].w);
                        store16_wt((void*)(H1B + (size_t)t * D + c0), o); } }
                __syncthreads();
                { const int r32 = lane & 31, half = lane >> 5;
                  const LAS float* hp = HR + r32 * 1028 + wave * 128 + 4 * half;
                  f32x16 a0 = f32x16{}; f32x4 g4 = (f32x4){0.f, 0.f, 0.f, 0.f};
#pragma unroll
                  for (int j = 0; j < 16; ++j) { const f32x4 hv = *(const LAS f32x4*)(hp + 8 * j), we = wE[j], wg = wG[j];
#pragma unroll
                      for (int q = 0; q < 4; ++q) { a0 = __builtin_amdgcn_mfma_f32_32x32x2f32(hv[q], we[q], a0, 0, 0, 0); g4 = __builtin_amdgcn_mfma_f32_4x4x1f32(hv[q], wg[q], g4, 0, 0, 0); }
                      if ((j & 3) == 3) __builtin_amdgcn_sched_barrier(0); }
                  __syncthreads();
#pragma unroll
                  for (int r = 0; r < 16; ++r) HR[(wave * 32 + r) * 64 + lane] = a0[r];
#pragma unroll
                  for (int i = 0; i < 4; ++i) HR[(wave * 32 + 16 + i) * 64 + lane] = g4[i];
                  __syncthreads();
                  if (wave < 5) {
#pragma unroll
                  for (int q = 0; q < 4; ++q) { const int rg = wave * 4 + q; float sm = 0.f;
#pragma unroll
                      for (int w2 = 0; w2 < 8; ++w2) sm += HR[(w2 * 32 + rg) * 64 + lane];
                      if (rg < 16) LG[crow(rg, half) * 37 + r32] = sm;
                      else { sm += __shfl_xor(sm, 32); if (lane < 32) LG[(4 * ((lane >> 2) & 7) + (rg - 16)) * 37 + 32 + (lane & 3)] = sm; } } }
                  __syncthreads(); }
                if (tid7 < 32) {
                    float pg[4], pe[32];
#pragma unroll
                    for (int e = 0; e < 32; ++e) pe[e] = LG[tid7 * 37 + e] + b_re[e];
#pragma unroll
                    for (int e = 0; e < 4; ++e) pg[e] = LG[tid7 * 37 + 32 + e] + b_rg[e];
                    int gs = 0; float gm = pg[0];
#pragma unroll
                    for (int e = 1; e < 4; ++e) if (pg[e] > gm) { gm = pg[e]; gs = e; }
                    float den = 0.f;
#pragma unroll
                    for (int e = 0; e < 4; ++e) den += expf(pg[e] - gm);
                    const float gwt = 1.f / den;
                    float ev[8];
#pragma unroll
                    for (int i = 0; i < 8; ++i) ev[i] = gs == 0 ? pe[i] : gs == 1 ? pe[8 + i] : gs == 2 ? pe[16 + i] : pe[24 + i];
                    int i0 = 0; float v0 = ev[0];
#pragma unroll
                    for (int i = 1; i < 8; ++i) if (ev[i] > v0) { v0 = ev[i]; i0 = i; }
                    int i1 = -1; float v1 = -INFINITY;
#pragma unroll
                    for (int i = 0; i < 8; ++i) if (i != i0 && ev[i] > v1) { v1 = ev[i]; i1 = i; }
                    const float ex = expf(v1 - v0), p0 = gwt / (1.f + ex), p1 = gwt * ex / (1.f + ex);
                    const int e0 = gs * 8 + i0, e1 = gs * 8 + i1;
                    const int lr0 = atomicAdd((int*)&CL[e0], 1), lr1 = atomicAdd((int*)&CL[e1], 1);
                    LAS int* rs = RES + (sb * 32 + tid7) * 6; rs[0] = e0; rs[1] = e1; rs[2] = lr0; rs[3] = lr1; rs[4] = __float_as_int(p0); rs[5] = __float_as_int(p1);
                }
            }
            __syncthreads();
            if (tid7 < 32) { const int c = CL[tid7]; CL[32 + tid7] = c ? (int)__hip_atomic_fetch_add(CNT + tid7, (unsigned)c, RLX_AGENT) : 0; }
            __syncthreads();
            if (tid7 < 128) { const int t = row0 + tid7; const LAS int* rs = RES + tid7 * 6; const int e0 = rs[0], e1 = rs[1];
                __hip_atomic_store((unsigned long long*)(LIST + e0 * LISTCAP + CL[32 + e0] + rs[2]), (unsigned long long)(unsigned)(2 * t) | ((unsigned long long)(unsigned)rs[4] << 32), RLX_AGENT);
                __hip_atomic_store((unsigned long long*)(LIST + e1 * LISTCAP + CL[32 + e1] + rs[3]), (unsigned long long)(unsigned)(2 * t + 1) | ((unsigned long long)(unsigned)rs[5] << 32), RLX_AGENT); }
            __syncthreads();
        }
    }
    xcd_barrier<false>(bar);
    }
    KA = kargs();
    { int wave = wave0, G = G0, vcu = vcu0, bidx = (int)blockIdx.x; asm volatile("" : "+s"(wave), "+s"(G), "+s"(vcu), "+s"(bidx));
      const int gw = vcu * NWAVES + wave, NGW = G * NWAVES, NGT = NGW * 64; (void)gw; (void)NGW; (void)NGT; (void)bidx;
    {
        { pg8::MoeSrc<0> S; S.init((const unsigned*)CNT, (LAS int*)(L + LDSCTL_OFF + 1024), G, vcu, 4, LIST, RDY, wave);
          pg8::Gemm g{H1B, WguT, 0, 0, D}; pg8::EpiSwiglu E{HM}; pg8::gemm_phase2<pg8::EpiSwiglu, pg8::MoeSrc<0>>(L + RING_OFF, g, S, E, wave); }
        { pg8::MoeSrc<1> S; S.init((const unsigned*)CNT, (LAS int*)(L + LDSCTL_OFF + 1024), G, vcu, 4, LIST, RDY, wave);
          pg8::Gemm g{HM, WdT, 0, 0, FF}; pg8::EpiDown E{YS, LIST}; pg8::gemm_phase2<pg8::EpiDown, pg8::MoeSrc<1>>(L + RING_OFF, g, S, E, wave); }
    }
    GRID_BAR();

    }
    KA = kargs();
    { int wave = wave0, G = G0, vcu = vcu0, bidx = (int)blockIdx.x; asm volatile("" : "+s"(wave), "+s"(G), "+s"(vcu), "+s"(bidx));
      const int gw = vcu * NWAVES + wave, NGW = G * NWAVES, NGT = NGW * 64; (void)gw; (void)NGW; (void)NGT; (void)bidx;
    { const int lane = lane_opaque();
    for (int t0 = gw * 4; t0 < T; t0 += NGW * 4) {
        v4u hw[4][2], y0[4][2], y1[4][2];
#pragma unroll
        for (int r = 0; r < 4; ++r)
#pragma unroll
            for (int j = 0; j < 2; ++j) { const int c0 = 8 * lane + 512 * j; const size_t t = (size_t)(t0 + r);
                hw[r][j] = *(const v4u*)(H1B + t * D + c0); y0[r][j] = *(const v4u*)(YS + (2 * t) * D + c0); y1[r][j] = *(const v4u*)(YS + (2 * t + 1) * D + c0); }
#pragma unroll
        for (int r = 0; r < 4; ++r) { const size_t t = (size_t)(t0 + r);
            f32x4 v[4]; float s = 0.f;
#pragma unroll
            for (int j = 0; j < 2; ++j)
#pragma unroll
                for (int q = 0; q < 2; ++q) { const unsigned h0 = hw[r][j][2 * q], h1 = hw[r][j][2 * q + 1], a0 = y0[r][j][2 * q], a1 = y0[r][j][2 * q + 1], b0 = y1[r][j][2 * q], b1 = y1[r][j][2 * q + 1];
                    f32x4& w = v[2 * j + q];
                    w.x = ALPHA * bflo(h0) + (bflo(a0) + bflo(b0)); w.y = ALPHA * bfhi(h0) + (bfhi(a0) + bfhi(b0));
                    w.z = ALPHA * bflo(h1) + (bflo(a1) + bflo(b1)); w.w = ALPHA * bfhi(h1) + (bfhi(a1) + bfhi(b1));
                    s += (w.x + w.y) + (w.z + w.w); }
            const float mean = wave_sum(s) * (1.f / D); float s2 = 0.f;
#pragma unroll
            for (int j = 0; j < 4; ++j) { v[j] = v[j] - mean; s2 += (v[j].x * v[j].x + v[j].y * v[j].y) + (v[j].z * v[j].z + v[j].w * v[j].w); }
            const float rstd = 1.f / sqrtf(wave_sum(s2) * (1.f / D) + LN_EPS);
#pragma unroll
            for (int j = 0; j < 2; ++j)
#pragma unroll
                for (int q = 0; q < 2; ++q) { const int c0 = 8 * lane + 512 * j + 4 * q; const f32x4 gg = *(const f32x4*)(ln2_g + c0), bb = *(const f32x4*)(ln2_b + c0);
                    *(f32x4*)(out + t * D + c0) = v[2 * j + q] * rstd * gg + bb; } }
    } }
    }
}

#undef XIN
#undef positions
#undef w_in
#undef b_gate
#undef lq1
#undef lk1
#undef lq2
#undef lk2
#undef subln_g
#undef w_o_att
#undef conv_w
#undef w_o_conv
#undef w_mix
#undef ln1_g
#undef ln1_b
#undef w_rg
#undef b_rg
#undef w_re
#undef b_re
#undef w_eg
#undef w_eu
#undef w_ed
#undef ln2_g
#undef ln2_b
#undef out
#undef ROPE
#undef LIST
#undef WRT
#undef WinT
#undef WcatT
#undef WmixT
#undef WguT
#undef WdT
#undef XB
#undef OR
#undef YS
#undef QB
#undef KB
#undef VB
#undef MG
#undef H1B
#undef CB
#undef UB
#undef OBF
#undef HM
#undef GB
#undef CNT
#undef RDY
extern "C" void kernel_launch(void* const* d_in, const int* in_sizes, int n_in, void* d_out, int out_size, void* d_ws, size_t ws_size, hipStream_t stream) {
    static int grid = 0;
    if (grid == 0) {
        if (n_in != 24 || in_sizes[0] != T * D || out_size != T * D || ws_size < WS_END) { fprintf(stderr, "kernel_launch: unexpected shapes (n_in %d, in0 %d, out %d, ws %zu); nothing launched\n", n_in, n_in > 0 ? in_sizes[0] : -1, out_size, ws_size); grid = -1; return; }
        int dev = 0, cus = 0, per_cu = 0;
        if (hipGetDevice(&dev) != hipSuccess || hipDeviceGetAttribute(&cus, hipDeviceAttributeMultiprocessorCount, dev) != hipSuccess) { grid = -1; return; }
        if (hipFuncSetAttribute((const void*)fwd, hipFuncAttributeMaxDynamicSharedMemorySize, LDS_BYTES) != hipSuccess) { fprintf(stderr, "kernel_launch: hipFuncSetAttribute failed\n"); grid = -1; return; }
        if (hipOccupancyMaxActiveBlocksPerMultiprocessor(&per_cu, (const void*)fwd, NWAVES * 64, LDS_BYTES) != hipSuccess || per_cu < 1) { fprintf(stderr, "kernel_launch: occupancy query says %d\n", per_cu); }
        (void)hipGetLastError();
        grid = cus;
    }
    if (grid < 0) return;
    if (hipMemsetAsync((char*)d_ws + WS_CTL, 0, CTL_ZERO_BYTES, stream) != hipSuccess) return;
    Args a{};
    for (int i = 0; i < 24; ++i) a.in[i] = (const float*)d_in[i];
    a.out = (float*)d_out; a.ws = (unsigned char*)d_ws;
    for (int i = 0; i < 32; ++i) a.invf[i] = pow(10000.0, -(double)i / 32.0);
    hipLaunchKernelGGL(fwd, dim3(grid), dim3(NWAVES * 64), LDS_BYTES, stream, a);
}
```

```cpp
#include <hip/hip_runtime.h>
#include <cstdio>
#include <cstdint>
#include <cmath>

#define GAS __attribute__((address_space(1)))
#define LAS __attribute__((address_space(3)))
typedef unsigned short bf16;
typedef unsigned v4u __attribute__((ext_vector_type(4)));
typedef unsigned v2u __attribute__((ext_vector_type(2)));
typedef float f32x4 __attribute__((ext_vector_type(4)));
typedef float f32x16 __attribute__((ext_vector_type(16)));
typedef short bf16x8 __attribute__((ext_vector_type(8)));
typedef GAS unsigned gu32;
#define RLX_AGENT __ATOMIC_RELAXED, __HIP_MEMORY_SCOPE_AGENT
#define LDS_WAIT() asm volatile("s_waitcnt lgkmcnt(0)" ::: "memory")
#define VM_WAIT() asm volatile("s_waitcnt vmcnt(0)" ::: "memory")


constexpr int NWAVES = 8;
constexpr int BATCH = 4, SEQ = 8192, T = BATCH * SEQ, D = 1024, NPROJ = 5120;
constexpr int NE = 32, FF = 512, LISTCAP = 32768;
constexpr float LN_EPS = 1e-5f, SUBLN_EPS = 1e-5f;
constexpr float ALPHA = 1.189207115002721f;
constexpr float LAMBDA_INIT = 0.2f;
constexpr float C2 = 0.125f * 1.4426950408889634f;

constexpr size_t MiB = 1u << 20;
constexpr size_t WS_CTL = 0, CTL_ZERO_BYTES = 1 * MiB;
constexpr size_t WS_ROPE = 1 * MiB;
constexpr size_t WS_LIST = 1 * MiB;
constexpr size_t WS_WGT = 13 * MiB;
constexpr size_t WS_WRT = 14 * MiB;
constexpr size_t WS_WIN = 16 * MiB;
constexpr size_t WS_WOA = 26 * MiB, WS_WOC = 27 * MiB, WS_WMIX = 28 * MiB;
constexpr size_t WS_WGU = 32 * MiB;
constexpr size_t WS_WD = 96 * MiB;
constexpr size_t WS_XB = 128 * MiB;
constexpr size_t WS_OR = 128 * MiB;
constexpr size_t WS_YS = 128 * MiB;
constexpr size_t WS_Q = 192 * MiB, WS_K = 224 * MiB, WS_V = 256 * MiB;
constexpr size_t WS_MG = 288 * MiB;
constexpr size_t WS_H1B = 288 * MiB;
constexpr size_t WS_CB = 288 * MiB, WS_U = 320 * MiB;
constexpr size_t WS_OB = 288 * MiB;
constexpr size_t WS_F = 352 * MiB;
constexpr size_t WS_HM = 352 * MiB;
constexpr size_t WS_G = 384 * MiB;
constexpr size_t WS_END = 512 * MiB;
constexpr int CW_XBAD = 512;
constexpr int CW_P2DONE = 640;
constexpr int CW_WDONE = 704;
constexpr int CW_P7DONE = 768;
constexpr int CW_CNT = 1024;
constexpr int CW_RDY = 16384;
constexpr int CW_BAR = 4096;

constexpr int RING_OFF = 0, RING_BYTES = 135168;
constexpr int LDSCTL_OFF = RING_BYTES, MISC_OFF = LDSCTL_OFF + 320;
constexpr int LDS_BYTES = 151552;

__device__ __forceinline__ unsigned f2bf(float f) { unsigned u = __builtin_bit_cast(unsigned, f); return (u + 0x7fffu + ((u >> 16) & 1u)) >> 16; }
__device__ __forceinline__ unsigned pk2(float lo, float hi) { return f2bf(lo) | (f2bf(hi) << 16); }
__device__ __forceinline__ float bflo(unsigned u) { return __uint_as_float(u << 16); }
__device__ __forceinline__ float bfhi(unsigned u) { return __uint_as_float(u & 0xffff0000u); }
__device__ __forceinline__ float bf2f(bf16 h) { return __uint_as_float((unsigned)h << 16); }

__device__ __forceinline__ int lane_id() { return (int)__builtin_amdgcn_mbcnt_hi(~0u, __builtin_amdgcn_mbcnt_lo(~0u, 0u)); }
#define XB_TMO      128
#define XB_XCNT(j)  (256  + 64 * (j))
#define XB_XSUB(j)  (1280 + 64 * (j))
#define XB_XGEN(j)  (2304 + 64 * (j))
#define XB_TOP      3328
#define XB_TOPGEN   3392
#define XB_LSUB(j)  (3456 + 64 * (j))
#define XB_LGEN(j)  (3968 + 64 * (j))
#define XB_PTOP(p)  (4480 + 64 * (p))
#define XB_PGEN(p)  (4736 + 64 * (p))
#define XCD_BAR_WORDS 4992
#define XB_SPIN_CAP (1u << 26)

__device__ __forceinline__ unsigned xb_ld(unsigned* p)              { return __hip_atomic_load(p, __ATOMIC_RELAXED, __HIP_MEMORY_SCOPE_AGENT); }
__device__ __forceinline__ unsigned xb_add(unsigned* p, unsigned v) { return __hip_atomic_fetch_add(p, v, __ATOMIC_RELAXED, __HIP_MEMORY_SCOPE_AGENT); }
__device__ __forceinline__ unsigned xb_xcc_id() { return (unsigned)__builtin_amdgcn_s_getreg((3 << 11) | 20) & 0xFu; }
#define XB_SPIN(cond, bar) do { unsigned _sp = 0; while (cond) { __builtin_amdgcn_s_sleep(1); \
    if ((++_sp & 255u) == 0u) { if (xb_ld(&(bar)[XB_TMO])) break; if (_sp > XB_SPIN_CAP) { atomicAdd(&(bar)[XB_TMO], 1u); break; } } } } while (0)

struct XcdBarrier { unsigned* bar; unsigned x; volatile LAS unsigned* st; int wave; };

__device__ __forceinline__ XcdBarrier xcd_barrier_post(unsigned* bar, volatile LAS unsigned* st) {
    XcdBarrier b; b.bar = bar; b.x = xb_xcc_id(); b.st = st; b.wave = __builtin_amdgcn_readfirstlane((int)threadIdx.x >> 6);
    const unsigned bad = (b.x != (unsigned)blockIdx.x % 8u || gridDim.x != 256u) ? 65536u : 0u;
    if (threadIdx.x == 0) (void)xb_add(&bar[XB_XCNT(b.x)], 1u + bad);
    return b;
}
__device__ __forceinline__ void xcd_barrier_complete(unsigned* bar, unsigned x, unsigned& nloc, unsigned& nx, unsigned& bad) {
    const unsigned G = gridDim.x * gridDim.y * gridDim.z;
    unsigned sum, cnt, mine, sp = 0u;
    for (;;) {
        sum = 0u; cnt = 0u; mine = 0u; bad = 0u;
#pragma unroll
        for (unsigned j = 0; j < 16; ++j) { const unsigned cc = xb_ld(&bar[XB_XCNT(j)]), c = cc & 0xffffu; bad |= cc >> 16; sum += c; cnt += (c > 0u) ? 1u : 0u; mine = (j == x) ? c : mine; }
        if (sum == G) break;
        __builtin_amdgcn_s_sleep(1);
        if ((++sp & 255u) == 0u) { if (xb_ld(&bar[XB_TMO])) break; if (sp > XB_SPIN_CAP) { atomicAdd(&bar[XB_TMO], 1u); break; } }
    }
    nloc = mine > 0u ? mine : 1u; nx = cnt > 0u ? cnt : 1u;
}
template <bool RELEASE = true> __device__ __forceinline__ void xcd_barrier(const XcdBarrier& b) {
    asm volatile("s_waitcnt vmcnt(0)" ::: "memory");
    __syncthreads();
    if (b.wave == 0 && lane_id() == 0) {
        unsigned* bar = b.bar;
        __builtin_amdgcn_s_waitcnt(0);
        unsigned nloc = b.st[0], nx = b.st[1];
        if (nloc == 0u) { unsigned bad; xcd_barrier_complete(bar, b.x, nloc, nx, bad); b.st[0] = nloc; b.st[1] = nx; b.st[2] = bad; }
        const unsigned old = xb_add(&bar[XB_XSUB(b.x)], 1u);
        const unsigned gen = old / nloc;
        if (old + 1u == (gen + 1u) * nloc) {
            if constexpr (RELEASE) __builtin_amdgcn_fence(__ATOMIC_RELEASE, "agent");
            asm volatile("s_waitcnt vmcnt(0)" ::: "memory");
            const unsigned og = xb_add(&bar[XB_TOP], 1u);
            const unsigned tg = og / nx;
            if (og + 1u == (tg + 1u) * nx) xb_add(&bar[XB_TOPGEN], 1u);
            else XB_SPIN(xb_ld(&bar[XB_TOPGEN]) == tg, bar);
            __builtin_amdgcn_fence(__ATOMIC_ACQUIRE, "agent");
            xb_add(&bar[XB_XGEN(b.x)], 1u);
            asm volatile("s_waitcnt vmcnt(0)" ::: "memory");
        } else {
            XB_SPIN(xb_ld(&bar[XB_XGEN(b.x)]) == gen, bar);
            __builtin_amdgcn_fence(__ATOMIC_ACQUIRE, "agent");
            asm volatile("s_waitcnt vmcnt(0)" ::: "memory");
        }
    }
    __syncthreads();
}

__device__ __forceinline__ void xcd_barrier_pair(const XcdBarrier& b) {
    asm volatile("s_waitcnt vmcnt(0)" ::: "memory");
    __syncthreads();
    if (b.wave == 0 && lane_id() == 0) {
        unsigned* bar = b.bar;
        __builtin_amdgcn_s_waitcnt(0);
        const unsigned nloc = b.st[0];
        const unsigned old = xb_add(&bar[XB_XSUB(b.x)], 1u);
        const unsigned gen = old / nloc;
        if (old + 1u == (gen + 1u) * nloc) {
            __builtin_amdgcn_fence(__ATOMIC_RELEASE, "agent");
            asm volatile("s_waitcnt vmcnt(0)" ::: "memory");
            const unsigned p = b.x >> 1;
            const unsigned og = xb_add(&bar[XB_PTOP(p)], 1u);
            const unsigned tg = og / 2u;
            if (og + 1u == (tg + 1u) * 2u) xb_add(&bar[XB_PGEN(p)], 1u);
            else XB_SPIN(xb_ld(&bar[XB_PGEN(p)]) == tg, bar);
            __builtin_amdgcn_fence(__ATOMIC_ACQUIRE, "agent");
            xb_add(&bar[XB_XGEN(b.x)], 1u);
            asm volatile("s_waitcnt vmcnt(0)" ::: "memory");
        } else {
            XB_SPIN(xb_ld(&bar[XB_XGEN(b.x)]) == gen, bar);
            __builtin_amdgcn_fence(__ATOMIC_ACQUIRE, "agent");
            asm volatile("s_waitcnt vmcnt(0)" ::: "memory");
        }
    }
    __syncthreads();
}

__device__ __forceinline__ void xcd_barrier_local(const XcdBarrier& b) {
    asm volatile("s_waitcnt vmcnt(0)" ::: "memory");
    __syncthreads();
    if (b.wave == 0 && lane_id() == 0) {
        unsigned* bar = b.bar;
        __builtin_amdgcn_s_waitcnt(0);
        const unsigned nloc = b.st[0];
        const unsigned old = xb_add(&bar[XB_LSUB(b.x)], 1u);
        const unsigned gen = old / nloc;
        if (old + 1u == (gen + 1u) * nloc) xb_add(&bar[XB_LGEN(b.x)], 1u);
        else XB_SPIN(xb_ld(&bar[XB_LGEN(b.x)]) == gen, bar);
        __builtin_amdgcn_fence(__ATOMIC_ACQUIRE, "agent");
        asm volatile("s_waitcnt vmcnt(0)" ::: "memory");
    }
    __syncthreads();
}

__host__ __device__ __forceinline__ int orig_of(int n) {
    const int tile = n >> 8, c = n & 255;
    if (tile < 4) { const int base = (tile >> 1) * 512 + (tile & 1) * 256, half = c >> 7, cc = c & 127, g = cc >> 5, i = cc & 31; return base + g * 64 + half * 32 + i; }
    if (tile >= 8 && tile < 12) { const int p = tile - 8, half = c >> 7; return 2048 + half * 512 + p * 128 + (c & 127); }
    if (tile >= 12) { const int p = tile - 12, half = c >> 7; return 3072 + half * 1024 + p * 128 + (c & 127); }
    return n;
}
__host__ __device__ __forceinline__ int n_of(int orig) {
    if (orig < 1024) { const int sec = orig >> 9, o = orig & 511, tl = o >> 8, o2 = o & 255, g = o2 >> 6, d = o2 & 63, half = d >> 5, i = d & 31; return (sec * 2 + tl) * 256 + half * 128 + g * 32 + i; }
    if (orig >= 2048 && orig < 3072) { const int o = orig - 2048, half = o >> 9, ch = o & 511, p = ch >> 7; return (8 + p) * 256 + half * 128 + (ch & 127); }
    if (orig >= 3072) { const int o = orig - 3072, half = o >> 10, ch = o & 1023, p = ch >> 7; return (12 + p) * 256 + half * 128 + (ch & 127); }
    return orig;
}

__device__ __forceinline__ float wave_sum(float v) {
#pragma unroll
    for (int o = 1; o < 64; o <<= 1) v += __shfl_xor(v, o);
    return v;
}
__device__ __forceinline__ void store16_wt(void* p, v4u v) { asm volatile("global_store_dwordx4 %0, %1, off sc1\n\ts_nop 1" :: "v"(p), "v"(v) : "memory"); }
template <bool SC1 = false> __device__ __forceinline__ void transpose_item(const float* W, int K, int N, bf16* WT, int k0, int n0, int dst_row0, LAS float* scr, int lane, int ldk = 0) {
    if (ldk == 0) ldk = K;
    f32x4 tv[8];
#pragma unroll
    for (int i = 0; i < 8; ++i) tv[i] = *(const f32x4*)(W + (size_t)(k0 + 8 * i + (lane >> 3)) * N + n0 + (lane & 7) * 4);
#pragma unroll
    for (int i = 0; i < 8; ++i)
#pragma unroll
        for (int e = 0; e < 4; ++e) scr[(8 * i + (lane >> 3)) * 33 + (lane & 7) * 4 + e] = tv[i][e];
    LDS_WAIT(); asm volatile("" ::: "memory");
    const int c = lane & 7;
#pragma unroll
    for (int j = 0; j < 4; ++j) { const int n = (lane >> 3) + 8 * j; const LAS float* s = scr + (8 * c) * 33 + n;
        v4u o; o.x = pk2(s[0 * 33], s[1 * 33]); o.y = pk2(s[2 * 33], s[3 * 33]); o.z = pk2(s[4 * 33], s[5 * 33]); o.w = pk2(s[6 * 33], s[7 * 33]);
        if constexpr (SC1) store16_wt((void*)(WT + (size_t)(dst_row0 + n) * ldk + k0 + 8 * c), o);
        else *(GAS v4u*)(WT + (size_t)(dst_row0 + n) * ldk + k0 + 8 * c) = o; }
    LDS_WAIT(); asm volatile("" ::: "memory");
}
__device__ __forceinline__ int crow(int r, int hi) { return (r & 3) + 8 * (r >> 2) + 4 * hi; }

__host__ __device__ __forceinline__ int own_tile(int ts) { const int x = ts >> 4, j = ts & 15, jj = x & 1, qb = j < 8 ? 8 * jj + j : 31 - 8 * jj - (j - 8); return 32 * (x >> 1) + qb; }

namespace pg8 {
#define PG8_LAS __attribute__((address_space(3)))
typedef unsigned short bf16_t;
typedef short bf16x8 __attribute__((ext_vector_type(8)));
typedef float f32x4 __attribute__((ext_vector_type(4)));
typedef unsigned u32x4 __attribute__((ext_vector_type(4)));
constexpr int BM = 256, BK = 64, HALF = 128, HTB = HALF * BK * 2  , STAGE_BYTES = 8 * HTB, NXCD = 8, WGM = 4;

__host__ __device__ __forceinline__ int lds_byte(int r, int c) { const int st = (r >> 4) * 2 + (c >> 5), rr = r & 15, cc = c & 31, ob = rr * 64 + cc * 2; return st * 1024 + (ob ^ (((ob >> 9) & 1) << 5)); }
__host__ __device__ __forceinline__ void stage_rc(int b, int& R, int& C) { const int st = b / 1024, sb = b % 1024, swz = sb ^ (((sb >> 9) & 1) << 5); R = (st >> 1) * 16 + swz / 64; C = (st & 1) * 32 + (swz % 64) / 2; }
__host__ __device__ __forceinline__ int perm32(int rho) { const int n = rho >> 4, i = rho & 15; return 8 * (i >> 2) + 4 * n + (i & 3); }

struct Unit { int pm, pn; };
struct Gemm { const bf16_t* A; const bf16_t* Bt; int M, N, K; };

struct StaticOrder {
    int nM, nN, nwg, G, c;
    __host__ __device__ void init(int M, int N, int G_, int c_) { nM = M / BM; nN = N / BM; nwg = nM * nN; G = G_; c = c_; }
    __host__ __device__ bool next(int i, Unit& u) const {
        const long L = (long)i * G + c; if (L >= nwg) return false;
        int wgid = (int)L; { const int q = nwg / NXCD, r = nwg % NXCD, xcd = wgid % NXCD, off = wgid / NXCD; wgid = (xcd < r ? xcd * (q + 1) : r * (q + 1) + (xcd - r) * q) + off; }
        const int nig = WGM * nN, gid = wgid / nig, fm = gid * WGM, gsz = (nM - fm) < WGM ? (nM - fm) : WGM;
        u.pm = fm + ((wgid % nig) % gsz); u.pn = (wgid % nig) / gsz; return true;
    }
    __device__ __forceinline__ void a_ready(const Unit&) const {}
    __device__ __forceinline__ void done(const Unit&) const {}
};

typedef float f32x2c __attribute__((ext_vector_type(2))); typedef __bf16 bf16x2c __attribute__((ext_vector_type(2)));
__device__ __forceinline__ unsigned cvt_pk_bf16(float lo, float hi) { const f32x2c v = {lo, hi}; const bf16x2c b = __builtin_convertvector(v, bf16x2c); return __builtin_bit_cast(unsigned, b); }
typedef float f32x2 __attribute__((ext_vector_type(2)));

typedef unsigned u32x2 __attribute__((ext_vector_type(2)));
__device__ __forceinline__ u32x4 pack8(const f32x4 a, const f32x4 b) { u32x4 w; w.x = cvt_pk_bf16(a[0], a[1]); w.y = cvt_pk_bf16(a[2], a[3]); w.z = cvt_pk_bf16(b[0], b[1]); w.w = cvt_pk_bf16(b[2], b[3]); return w; }
__device__ __forceinline__ float sigmoidf_fast(float z) { return __builtin_amdgcn_rcpf(1.0f + __expf(-z)); }
struct EpiProj {
    static constexpr bool PERM = true, AFTER_DRAIN = false; static constexpr int RELAX = 8;
    bf16_t *Q, *K, *V, *CB, *U, *G; const float* rope; const float* bgate; float c2;
    __device__ __forceinline__ void operator()(const f32x4 (&acc)[2][2][4][2], const Unit& u, int wr, int wc, int fr, int fq) const {
        const int row0 = u.pm * BM + wr * 64 + fr, tile = u.pn;
        if (tile < 4) {
            bf16_t* dst = (tile < 2 ? Q : K) + ((tile & 1) * 4 + wc) * 64 + 8 * fq; const float sc = tile < 2 ? c2 : 1.f;
#pragma unroll
            for (int ai = 0; ai < 2; ++ai) {
                f32x4 cst[4][4];
#pragma unroll
                for (int m = 0; m < 4; ++m) { const f32x4* cs = (const f32x4*)(rope + (size_t)(row0 + ai * HALF + m * 16) * 64 + 16 * fq);
#pragma unroll
                    for (int q = 0; q < 4; ++q) cst[m][q] = cs[q]; }
#pragma unroll
                for (int m = 0; m < 4; ++m) { const int t = row0 + ai * HALF + m * 16;
                    f32x4 lo[2], hi[2], ol[2], oh[2];
                    lo[0] = acc[ai][0][m][0]; lo[1] = acc[ai][0][m][1]; hi[0] = acc[ai][1][m][0]; hi[1] = acc[ai][1][m][1];
#pragma unroll
                    for (int n = 0; n < 2; ++n) { const f32x4 ca = cst[m][2 * n], cb = cst[m][2 * n + 1];
                        ol[n][0] = (lo[n][0] * ca.x - hi[n][0] * ca.y) * sc; oh[n][0] = (hi[n][0] * ca.x + lo[n][0] * ca.y) * sc;
                        ol[n][1] = (lo[n][1] * ca.z - hi[n][1] * ca.w) * sc; oh[n][1] = (hi[n][1] * ca.z + lo[n][1] * ca.w) * sc;
                        ol[n][2] = (lo[n][2] * cb.x - hi[n][2] * cb.y) * sc; oh[n][2] = (hi[n][2] * cb.x + lo[n][2] * cb.y) * sc;
                        ol[n][3] = (lo[n][3] * cb.z - hi[n][3] * cb.w) * sc; oh[n][3] = (hi[n][3] * cb.z + lo[n][3] * cb.w) * sc; }
                    bf16_t* rowp = dst + (size_t)t * 512;
                    *(u32x4*)rowp = pack8(ol[0], ol[1]); *(u32x4*)(rowp + 32) = pack8(oh[0], oh[1]); } }
        } else if (tile < 8) {
            bf16_t* dst = (tile < 6 ? V : CB) + (tile & 1) * 256 + wc * 32 + 8 * fq;
#pragma unroll
            for (int ai = 0; ai < 2; ++ai)
#pragma unroll
                for (int m = 0; m < 4; ++m) { bf16_t* rowp = dst + (size_t)(row0 + ai * HALF + m * 16) * 512;
#pragma unroll
                    for (int bj = 0; bj < 2; ++bj) *(u32x4*)(rowp + bj * HALF) = pack8(acc[ai][bj][m][0], acc[ai][bj][m][1]); }
        } else if (tile < 12) {
            bf16_t* dst = U + (tile - 8) * 128 + wc * 32 + 8 * fq;
#pragma unroll
            for (int ai = 0; ai < 2; ++ai)
#pragma unroll
                for (int m = 0; m < 4; ++m) *(u32x4*)(dst + (size_t)(row0 + ai * HALF + m * 16) * 512) = pack8(acc[ai][0][m][0] * acc[ai][1][m][0], acc[ai][0][m][1] * acc[ai][1][m][1]);
        } else {
            const int c0 = (tile - 12) * 128 + wc * 32 + 8 * fq;
            f32x4 bv[2][2];
#pragma unroll
            for (int bj = 0; bj < 2; ++bj)
#pragma unroll
                for (int n = 0; n < 2; ++n) bv[bj][n] = *(const f32x4*)(bgate + bj * 1024 + c0 + 4 * n);
#pragma unroll
            for (int ai = 0; ai < 2; ++ai)
#pragma unroll
                for (int m = 0; m < 4; ++m) { bf16_t* rowp = G + (size_t)(row0 + ai * HALF + m * 16) * 2048 + c0;
                    f32x4 g[2], r[2];
#pragma unroll
                    for (int n = 0; n < 2; ++n) { const f32x4 z0 = acc[ai][0][m][n] + bv[0][n], z1 = acc[ai][1][m][n] + bv[1][n];
#pragma unroll
                        for (int e = 0; e < 4; ++e) { const float u0 = 1.0f + __expf(-z0[e]), g1 = __builtin_amdgcn_rcpf(1.0f + __expf(-z1[e]));
                            g[n][e] = __builtin_fmaxf(__builtin_amdgcn_rcpf(u0), 9.5367431640625e-07f); r[n][e] = __builtin_fminf(u0, 1048576.0f) * g1; } }
                    *(u32x4*)rowp = pack8(g[0], g[1]); *(u32x4*)(rowp + 1024) = pack8(r[0], r[1]); }
        }
    }
};
template <class Epi, class Sched, bool ALIGN_EPI = false, bool SP2 = false>
__device__ __forceinline__ void gemm_phase(PG8_LAS unsigned char* lds, const Gemm g, const Sched& S, const Epi& E, const int wid_in) {
    int tid_ = wid_in * 64 + (int)__builtin_amdgcn_mbcnt_hi(~0u, __builtin_amdgcn_mbcnt_lo(~0u, 0u)); asm volatile("" : "+v"(tid_));
    const int tid = tid_, wid = __builtin_amdgcn_readfirstlane(tid >> 6), lane = tid & 63, wr = wid >> 2, wc = wid & 3, fr = lane & 15, fq = lane >> 4;
    const int K = g.K, nt = K / BK;
    unsigned voffA[2], voffB[2];
#pragma unroll
    for (int i = 0; i < 2; ++i) { int R, C; stage_rc(tid * 16 + i * 8192, R, C); const int Rb = Epi::PERM ? ((R & ~31) + perm32(R & 31)) : R;
        voffA[i] = (unsigned)(R * K + C) * 2u; voffB[i] = (unsigned)(Rb * K + C) * 2u; }
    const size_t kstep = (size_t)(BK * 2);
    const size_t hstep = (size_t)HALF * K * 2;
    const size_t tstep = 2 * hstep;
    const unsigned ldsw = (unsigned)wid * 1024u;
    const int aoff = lds_byte(wr * 64 + fr, fq * 8), boff = lds_byte(wc * 32 + fr, fq * 8);
#define PG8_SA(b, h) (((b) * 2 + (h)) * HTB)
#define PG8_SB(b, h) ((4 + (b) * 2 + (h)) * HTB)
#define PG8_STAGE(bufoff, gbase, voff) do { _Pragma("unroll") for (int _i = 0; _i < 2; ++_i) \
        __builtin_amdgcn_global_load_lds((const unsigned*)((const char*)(gbase) + (voff)[_i]), (PG8_LAS unsigned*)(lds + (bufoff) + ldsw + _i * 8192), 16, 0, 0); } while (0)
#define PG8_LDA(dst, b, h) do { _Pragma("unroll") for (int m = 0; m < 4; ++m) _Pragma("unroll") for (int k = 0; k < 2; ++k) dst[m][k] = *(const PG8_LAS bf16x8*)(lds + PG8_SA(b, h) + aoff + m * 2048 + k * 1024); } while (0)
#define PG8_LDB(dst, b, h) do { _Pragma("unroll") for (int n = 0; n < 2; ++n) _Pragma("unroll") for (int k = 0; k < 2; ++k) dst[n][k] = *(const PG8_LAS bf16x8*)(lds + PG8_SB(b, h) + boff + n * 2048 + k * 1024); } while (0)
#define PG8_MMA(ai, bj, At, Bt) do { __builtin_amdgcn_s_setprio(1); _Pragma("unroll") for (int m = 0; m < 4; ++m) _Pragma("unroll") for (int n = 0; n < 2; ++n) _Pragma("unroll") for (int k = 0; k < 2; ++k) \
        acc[ai][bj][m][n] = __builtin_amdgcn_mfma_f32_16x16x32_bf16(Bt[n][k], At[m][k], acc[ai][bj][m][n], 0, 0, 0); __builtin_amdgcn_s_setprio(0); } while (0)
#define PG8_WAIT_V(n) asm volatile("s_waitcnt vmcnt(" #n ")" ::: "memory")
#define PG8_WAIT_VR(flag) do { static_assert(Epi::RELAX == 0 || Epi::RELAX == 8, "one relaxed count is written out"); \
        if constexpr (Epi::RELAX == 8) { const int f_ = __builtin_amdgcn_readfirstlane(flag); asm volatile("s_cmp_eq_u32 %0, 0\n\ts_cbranch_scc1 .Lwr%=\n\ts_waitcnt vmcnt(16)\n\ts_branch .Lwe%=\n.Lwr%=:\n\ts_waitcnt vmcnt(8)\n.Lwe%=:" :: "s"(f_) : "scc", "memory"); } \
        else asm volatile("s_waitcnt vmcnt(8)" ::: "memory"); } while (0)
#define PG8_WAIT_L(n) asm volatile("s_waitcnt lgkmcnt(" #n ")" ::: "memory")
#define PG8_BAR __builtin_amdgcn_s_barrier()
#define PG8_SCHED __builtin_amdgcn_sched_barrier(0)
    Unit cur, nxt; int ui = 0;
    if (!S.next(0, cur)) return;
    f32x4 acc[2][2][4][2];
#pragma unroll
    for (int a = 0; a < 2; ++a)
#pragma unroll
        for (int b = 0; b < 2; ++b)
#pragma unroll
            for (int m = 0; m < 4; ++m)
#pragma unroll
                for (int n = 0; n < 2; ++n) acc[a][b][m][n] = (f32x4){0.f, 0.f, 0.f, 0.f};
    bf16x8 At[4][2], B0[2][2], B1[2][2];
    const char* cA = (const char*)g.A + (size_t)cur.pm * tstep; const char* cB = (const char*)g.Bt + (size_t)cur.pn * tstep;
    S.a_ready(cur);
    if constexpr (SP2) {
        PG8_STAGE(PG8_SB(0, 0), cB, voffB); PG8_STAGE(PG8_SB(0, 1), cB + hstep, voffB); PG8_STAGE(PG8_SA(0, 0), cA, voffA); PG8_STAGE(PG8_SA(0, 1), cA + hstep, voffA);
        if (wr == 1) PG8_BAR;
        PG8_WAIT_V(2); PG8_BAR;
        PG8_STAGE(PG8_SB(1, 0), cB + kstep, voffB); PG8_STAGE(PG8_SA(1, 0), cA + kstep, voffA); PG8_STAGE(PG8_SB(1, 1), cB + hstep + kstep, voffB);
        PG8_WAIT_V(6); PG8_BAR;
    } else {
        PG8_STAGE(PG8_SB(0, 0), cB, voffB); PG8_STAGE(PG8_SA(0, 0), cA, voffA); PG8_STAGE(PG8_SB(0, 1), cB + hstep, voffB); PG8_STAGE(PG8_SA(0, 1), cA + hstep, voffA);
        if (wr == 1) PG8_BAR;
        PG8_WAIT_V(4); PG8_BAR;
        PG8_STAGE(PG8_SB(1, 0), cB + kstep, voffB); PG8_STAGE(PG8_SA(1, 0), cA + kstep, voffA); PG8_STAGE(PG8_SB(1, 1), cB + hstep + kstep, voffB);
        PG8_WAIT_V(6); PG8_BAR;
    }
    for (;;) {
        const bool has_next = S.next(ui + 1, nxt);
        const char* nA = has_next ? (const char*)g.A + (size_t)nxt.pm * tstep : cA; const char* nB = has_next ? (const char*)g.Bt + (size_t)nxt.pn * tstep : cB;
        for (int t = 0; t < nt; t += 2) {
            const bool last = (t == nt - 2);
            const char* a1 = cA + (size_t)(t + 1) * kstep;
            const char* a2 = last ? nA : cA + (size_t)(t + 2) * kstep; const char* b2 = last ? nB : cB + (size_t)(t + 2) * kstep;
            const char* a3 = a2 + kstep; const char* b3 = b2 + kstep;
            if (last && has_next) S.a_ready(nxt);
            if constexpr (SP2) {
            PG8_LDB(B0, 0, 0); PG8_LDB(B1, 0, 1); PG8_SCHED; PG8_LDA(At, 0, 0); PG8_STAGE(PG8_SA(1, 1), a1 + hstep, voffA);
            PG8_WAIT_VR((t == 0 && ui > 0) ? 1 : 0); PG8_WAIT_L(0); PG8_BAR; PG8_MMA(0, 0, At, B0); PG8_MMA(0, 1, At, B1); PG8_BAR; PG8_SCHED;
            PG8_LDA(At, 0, 1); PG8_STAGE(PG8_SB(0, 0), b2, voffB); PG8_STAGE(PG8_SB(0, 1), b2 + hstep, voffB); PG8_STAGE(PG8_SA(0, 0), a2, voffA);
            PG8_WAIT_VR((t == 0 && ui > 0) ? 1 : 0); PG8_WAIT_L(0); PG8_BAR; PG8_MMA(1, 0, At, B0); PG8_MMA(1, 1, At, B1); PG8_BAR; PG8_SCHED;
            PG8_LDB(B0, 1, 0); PG8_LDB(B1, 1, 1); PG8_SCHED; PG8_LDA(At, 1, 0); PG8_STAGE(PG8_SA(0, 1), a2 + hstep, voffA);
            PG8_WAIT_V(8); PG8_WAIT_L(0); PG8_BAR; PG8_MMA(0, 0, At, B0); PG8_MMA(0, 1, At, B1); PG8_BAR; PG8_SCHED;
            PG8_LDA(At, 1, 1); PG8_STAGE(PG8_SB(1, 0), b3, voffB); PG8_STAGE(PG8_SB(1, 1), b3 + hstep, voffB); PG8_STAGE(PG8_SA(1, 0), a3, voffA);
            PG8_WAIT_V(8); PG8_WAIT_L(0); PG8_BAR; PG8_MMA(1, 0, At, B0); PG8_MMA(1, 1, At, B1); PG8_BAR; PG8_SCHED;
            } else {
            PG8_LDB(B0, 0, 0); PG8_SCHED; PG8_LDA(At, 0, 0); PG8_STAGE(PG8_SA(1, 1), a1 + hstep, voffA);
            PG8_WAIT_L(8); PG8_BAR; PG8_WAIT_L(0); PG8_MMA(0, 0, At, B0); PG8_BAR; PG8_SCHED;
            PG8_LDB(B1, 0, 1); PG8_STAGE(PG8_SB(0, 0), b2, voffB);
            PG8_BAR; PG8_WAIT_L(0); PG8_MMA(0, 1, At, B1); PG8_BAR;
            PG8_LDA(At, 0, 1); PG8_STAGE(PG8_SA(0, 0), a2, voffA);
            PG8_BAR; PG8_WAIT_L(0); PG8_MMA(1, 0, At, B0); PG8_BAR; PG8_SCHED;
            PG8_STAGE(PG8_SB(0, 1), b2 + hstep, voffB);
            PG8_WAIT_V(6); PG8_BAR; PG8_MMA(1, 1, At, B1); PG8_BAR;
            PG8_LDB(B0, 1, 0); PG8_SCHED; PG8_LDA(At, 1, 0); PG8_STAGE(PG8_SA(0, 1), a2 + hstep, voffA);
            PG8_WAIT_L(8); PG8_BAR; PG8_WAIT_L(0); PG8_MMA(0, 0, At, B0); PG8_BAR; PG8_SCHED;
            PG8_LDB(B1, 1, 1); PG8_STAGE(PG8_SB(1, 0), b3, voffB);
            PG8_BAR; PG8_WAIT_L(0); PG8_MMA(0, 1, At, B1); PG8_BAR;
            PG8_LDA(At, 1, 1); PG8_STAGE(PG8_SA(1, 0), a3, voffA);
            PG8_BAR; PG8_WAIT_L(0); PG8_MMA(1, 0, At, B0); PG8_BAR; PG8_SCHED;
            PG8_STAGE(PG8_SB(1, 1), b3 + hstep, voffB);
            PG8_WAIT_V(6); PG8_BAR; PG8_MMA(1, 1, At, B1); PG8_BAR;
            }
        }
        if constexpr (ALIGN_EPI) { if (wr == 0) PG8_BAR; }
        if constexpr (!Epi::AFTER_DRAIN) { E(acc, cur, wr, wc, fr, fq); S.done(cur); }
        if (!has_next) break;
#pragma unroll
        for (int a = 0; a < 2; ++a)
#pragma unroll
            for (int b = 0; b < 2; ++b)
#pragma unroll
                for (int m = 0; m < 4; ++m)
#pragma unroll
                    for (int n = 0; n < 2; ++n) acc[a][b][m][n] = (f32x4){0.f, 0.f, 0.f, 0.f};
        cur = nxt; cA = nA; cB = nB; ++ui;
        if constexpr (ALIGN_EPI) { if (wr == 1) PG8_BAR; }
    }
    PG8_WAIT_V(0);
    if constexpr (!ALIGN_EPI) { if (wr == 0) PG8_BAR; }
    PG8_BAR;
    if constexpr (Epi::AFTER_DRAIN) { E.fused(acc, cur, wr, wc, fr, fq, lds, wid, lane); S.done(cur); }
#undef PG8_SA
#undef PG8_SB
#undef PG8_STAGE
#undef PG8_LDA
#undef PG8_LDB
#undef PG8_MMA
#undef PG8_WAIT_V
#undef PG8_WAIT_VR
#undef PG8_WAIT_L
#undef PG8_BAR
#undef PG8_SCHED
}
}


namespace pg8 {
struct Unit2 { int pm, pn; int arow; int e; int r0; int nv; int rtg; };
struct PlainSrc : StaticOrder {
    int rev = 0;
    __device__ __forceinline__ bool next(int i, Unit2& u) const { Unit t; const int nc = c < nwg ? (nwg - 1 - c) / G + 1 : 0; if (i >= nc) return false; if (!StaticOrder::next(rev ? nc - 1 - i : i, t)) return false; u.pm = own_tile(t.pm); u.pn = t.pn; u.arow = u.pm * BM; u.e = 0; u.r0 = 0; u.nv = BM; u.rtg = 0; return true; }
    static constexpr bool PUBLISH = false; static constexpr int A_AUX = 0; static constexpr size_t A_KSTEP = BK * 2;
    __device__ __forceinline__ void publish(int, int) const {}
    __device__ __forceinline__ void a_issue(const Unit2&, const int (&)[2], int (&)[2][2]) const {}
    __device__ __forceinline__ const char* a_finish(const Gemm& g, const Unit2& u, const int (&R)[2], const int (&C)[2], const int (&)[2][2], unsigned (&v)[2][2]) const {
#pragma unroll
        for (int h = 0; h < 2; ++h)
#pragma unroll
            for (int i = 0; i < 2; ++i) v[h][i] = (unsigned)((h * HALF + R[i]) * g.K + C[i]) * 2u;
        return (const char*)g.A + (size_t)u.arow * g.K * 2;
    }
};
constexpr unsigned HM_STRIPB = 256u * 64u, HM_TILEB = 16u * HM_STRIPB;
constexpr int RDY_STRIDE = 16, RDY_TARGET = 32, RDY_SPIN_CAP = 1 << 22;
template <int STAGE> struct MoeSrc {
    static constexpr bool PUBLISH = (STAGE == 0); static constexpr int A_AUX = 0; static constexpr size_t A_KSTEP = (STAGE == 1) ? 2 * (size_t)HM_STRIPB : (size_t)(BK * 2);
    int G, c, ntn; const int2* list; PG8_LAS int* tab; unsigned* rdy;
    int r8, gapn, q, r9, cc, hasgap;
    __device__ __forceinline__ void init(const unsigned* cnt, PG8_LAS int* tab_, int G_, int c_, int ntn_, const int2* list_, unsigned* rdy_, int wid) {
        G = G_; c = c_; ntn = ntn_; list = list_; tab = tab_; rdy = rdy_;
        if constexpr (STAGE == 0) {
        if (wid == 0) { const int lane = (int)__builtin_amdgcn_mbcnt_hi(~0u, __builtin_amdgcn_mbcnt_lo(~0u, 0u));
            const int a = (lane < 32) ? (int)__hip_atomic_load(cnt + lane, __ATOMIC_RELAXED, __HIP_MEMORY_SCOPE_AGENT) : 0, t4 = ((a + BM - 1) / BM) * ntn_;
            int ia = a, it = t4;
#pragma unroll
            for (int o = 1; o < 32; o <<= 1) { const int x = __shfl_up(ia, o), y = __shfl_up(it, o); if ((lane & 31) >= o) { ia += x; it += y; } }
            if (lane < 32) { tab_[4 * lane] = a; tab_[4 * lane + 1] = ia - a; tab_[4 * lane + 2] = it; tab_[4 * lane + 3] = it - t4; } }
        __syncthreads();
        r8 = gapn = q = r9 = cc = hasgap = 0;
        } else {
            const int n = __builtin_amdgcn_readfirstlane(tab_[4 * 31 + 2]);
            r8 = n % G_; const int gap = r8 ? G_ - r8 : 0; gapn = gap < n ? gap : n; const int n9 = n - gapn; q = n9 / G_; r9 = n9 - q * G_;
            cc = r8 ? (c_ - r8 + G_) % G_ : c_; hasgap = (r8 > 0 && c_ >= r8 && c_ - r8 < n) ? 1 : 0;
        }
    }
    __device__ __forceinline__ bool next(int i, Unit2& u) const {
        const int total = tab[4 * 31 + 2]; int L;
        if constexpr (STAGE == 0) { L = i * G + c; if (L >= total) return false; }
        else { int ii = i - hasgap;
            if (ii < 0) L = c - r8; else if (ii < q) L = gapn + ii * G + c; else if (ii == q && cc < r9) L = gapn + q * G + cc; else return false; }
        const int lane = (int)__builtin_amdgcn_mbcnt_hi(~0u, __builtin_amdgcn_mbcnt_lo(~0u, 0u)); const int inc = tab[4 * (lane & 31) + 2];
        const unsigned long long m = __ballot(lane < 32 && L >= inc); const int e = __builtin_amdgcn_readfirstlane(__popcll(m));
        const int cnt = __builtin_amdgcn_readfirstlane(tab[4 * e]), ex = __builtin_amdgcn_readfirstlane(tab[4 * e + 1]), ux = __builtin_amdgcn_readfirstlane(tab[4 * e + 3]), l0 = L - ux;
        const int rt = l0 / ntn, pn = l0 - rt * ntn;
        u.e = e; u.pm = rt; u.pn = e * ntn + pn; u.r0 = rt * BM; u.nv = (cnt - rt * BM) < BM ? (cnt - rt * BM) : BM; u.arow = ex + rt * BM; u.rtg = ux / ntn + rt; return true;
    }
    __device__ __forceinline__ void publish(int rtg, int lane) const { if (lane == 0) (void)__hip_atomic_fetch_add(rdy + rtg * RDY_STRIDE, 1u, __ATOMIC_RELAXED, __HIP_MEMORY_SCOPE_AGENT); }
    __device__ __forceinline__ void a_issue(const Unit2& u, const int (&R)[2], int (&aid)[2][2]) const {
        if constexpr (STAGE == 0) {
#pragma unroll
            for (int h = 0; h < 2; ++h)
#pragma unroll
                for (int i = 0; i < 2; ++i) { int r = h * HALF + R[i]; r = r < u.nv ? r : u.nv - 1; aid[h][i] = list[u.e * 32768 + u.r0 + r].x; }
        } else aid[0][0] = (int)__hip_atomic_load(rdy + u.rtg * RDY_STRIDE, __ATOMIC_RELAXED, __HIP_MEMORY_SCOPE_AGENT);
    }
    __device__ __forceinline__ const char* a_finish(const Gemm& g, const Unit2& u, const int (&R)[2], const int (&C)[2], const int (&aid)[2][2], unsigned (&v)[2][2]) const {
        if constexpr (STAGE == 0) {
#pragma unroll
            for (int h = 0; h < 2; ++h)
#pragma unroll
                for (int i = 0; i < 2; ++i) v[h][i] = ((unsigned)(aid[h][i] >> 1) * (unsigned)g.K + (unsigned)C[i]) * 2u;
            return (const char*)g.A;
        } else {
            int seen = __builtin_amdgcn_readfirstlane(aid[0][0]);
            if (seen < RDY_TARGET) { int sp = 0;
                do { __builtin_amdgcn_s_sleep(2); seen = __builtin_amdgcn_readfirstlane((int)__hip_atomic_load(rdy + u.rtg * RDY_STRIDE, __ATOMIC_RELAXED, __HIP_MEMORY_SCOPE_AGENT)); } while (seen < RDY_TARGET && ++sp < RDY_SPIN_CAP); }
#pragma unroll
            for (int h = 0; h < 2; ++h)
#pragma unroll
                for (int i = 0; i < 2; ++i) { int r = h * HALF + R[i]; r = r < u.nv ? r : u.nv - 1; v[h][i] = (unsigned)(C[i] >> 5) * HM_STRIPB + (unsigned)(r * 64 + (C[i] & 31) * 2); }
            return (const char*)g.A + (size_t)u.rtg * HM_TILEB;
        }
    }
};
__device__ __forceinline__ void unpack8(const u32x4 w, f32x4& a, f32x4& b) { a[0] = __uint_as_float(w.x << 16); a[1] = __uint_as_float(w.x & 0xffff0000u); a[2] = __uint_as_float(w.y << 16); a[3] = __uint_as_float(w.y & 0xffff0000u);
    b[0] = __uint_as_float(w.z << 16); b[1] = __uint_as_float(w.z & 0xffff0000u); b[2] = __uint_as_float(w.w << 16); b[3] = __uint_as_float(w.w & 0xffff0000u); }
template <bool ACCUM> struct EpiGate {
    static constexpr bool PERM = true, AFTER_DRAIN = false, HAS_MID = false; static constexpr int RELAX = 0;
    bf16_t* MGp; const bf16_t* Gp; int goff;
    __device__ __forceinline__ void operator()(const f32x4 (&acc)[2][2][4][2], const Unit2& u, int wr, int wc, int fr, int fq) const {
        const int row0 = u.pm * BM + wr * 64 + fr, col0 = (u.pn & 3) * BM + wc * 32 + 8 * fq;
#pragma unroll
        for (int ai = 0; ai < 2; ++ai)
#pragma unroll
        for (int mh = 0; mh < (ACCUM ? 2 : 1); ++mh) {
            constexpr int MB = ACCUM ? 2 : 4; const int m0 = mh * MB;
            u32x4 gw[4][2], ow[4][2];
#pragma unroll
            for (int m = m0; m < m0 + MB; ++m) { const size_t t = (size_t)(row0 + ai * HALF + m * 16);
#pragma unroll
                for (int bj = 0; bj < 2; ++bj) { gw[m][bj] = *(const u32x4*)(Gp + t * 2048 + goff + col0 + bj * HALF); if (ACCUM) ow[m][bj] = *(const u32x4*)(MGp + t * 1024 + col0 + bj * HALF); } }
#pragma unroll
            for (int m = m0; m < m0 + MB; ++m) { const size_t t = (size_t)(row0 + ai * HALF + m * 16);
#pragma unroll
                for (int bj = 0; bj < 2; ++bj) { f32x4 g0, g1; unpack8(gw[m][bj], g0, g1);
                    f32x4 v0 = acc[ai][bj][m][0] * g0, v1 = acc[ai][bj][m][1] * g1;
                    if (ACCUM) { f32x4 o0, o1; unpack8(ow[m][bj], o0, o1); v0 += o0; v1 += o1; }
                    *(u32x4*)(MGp + t * 1024 + col0 + bj * HALF) = pack8(v0, v1); } } }
    }
};
struct EpiMerge {
    static constexpr bool PERM = true, AFTER_DRAIN = false, HAS_MID = true; static constexpr int RELAX = 8;
    bf16_t* MGp; const bf16_t* Gp;
    __device__ __forceinline__ void mid(f32x4 (&acc)[2][2][4][2], const Unit2& u, int wr, int wc, int fr, int fq) const {
        int row0 = u.pm * BM + wr * 64 + fr, col0 = (u.pn & 3) * BM + wc * 32 + 8 * fq; asm volatile("" : "+v"(row0), "+v"(col0));
        u32x4 rw[2][4][2];
#pragma unroll
        for (int ai = 0; ai < 2; ++ai)
#pragma unroll
            for (int m = 0; m < 4; ++m) { const size_t t = (size_t)(row0 + ai * HALF + m * 16);
#pragma unroll
                for (int bj = 0; bj < 2; ++bj) rw[ai][m][bj] = *(const u32x4*)(Gp + t * 2048 + 1024 + col0 + bj * HALF); }
#pragma unroll
        for (int ai = 0; ai < 2; ++ai)
#pragma unroll
            for (int m = 0; m < 4; ++m)
#pragma unroll
                for (int bj = 0; bj < 2; ++bj) { f32x4 b0, b1; unpack8(rw[ai][m][bj], b0, b1); acc[ai][bj][m][0] *= b0; acc[ai][bj][m][1] *= b1; }
        asm volatile("" ::: "memory");
    }
    __device__ __forceinline__ void operator()(const f32x4 (&acc)[2][2][4][2], const Unit2& u, int wr, int wc, int fr, int fq) const {
        const int row0 = u.pm * BM + wr * 64 + fr, col0 = (u.pn & 3) * BM + wc * 32 + 8 * fq;
#pragma unroll
        for (int ai = 0; ai < 2; ++ai) {
            u32x4 g0w[4][2];
#pragma unroll
            for (int m = 0; m < 4; ++m)
#pragma unroll
                for (int bj = 0; bj < 2; ++bj) g0w[m][bj] = *(const u32x4*)(Gp + (size_t)(row0 + ai * HALF + m * 16) * 2048 + col0 + bj * HALF);
#pragma unroll
            for (int m = 0; m < 4; ++m)
#pragma unroll
                for (int bj = 0; bj < 2; ++bj) { f32x4 a0, a1; unpack8(g0w[m][bj], a0, a1);
#pragma unroll
                    for (int e = 0; e < 4; ++e) { a0[e] = __builtin_fmaxf(a0[e], 9.5367431640625e-07f); a1[e] = __builtin_fmaxf(a1[e], 9.5367431640625e-07f); }
                    *(u32x4*)(MGp + (size_t)(row0 + ai * HALF + m * 16) * 1024 + col0 + bj * HALF) = pack8(acc[ai][bj][m][0] * a0, acc[ai][bj][m][1] * a1); } }
    }
};
struct EpiRes {
    static constexpr bool PERM = false, AFTER_DRAIN = false, HAS_MID = false; static constexpr int RELAX = 0;
    const float* x; float* out; float alpha;
    __device__ __forceinline__ void operator()(const f32x4 (&acc)[2][2][4][2], const Unit2& u, int wr, int wc, int fr, int fq) const {
        const int row0 = u.pm * BM + wr * 64 + fr, col0 = u.pn * BM + wc * 32 + 4 * fq;
#pragma unroll
        for (int ai = 0; ai < 2; ++ai)
#pragma unroll
            for (int m = 0; m < 4; ++m) { const size_t off = (size_t)(row0 + ai * HALF + m * 16) * 1024 + col0;
#pragma unroll
                for (int bj = 0; bj < 2; ++bj)
#pragma unroll
                    for (int n = 0; n < 2; ++n) { const f32x4 xv = *(const f32x4*)(x + off + bj * HALF + n * 16); *(f32x4*)(out + off + bj * HALF + n * 16) = xv * alpha + acc[ai][bj][m][n]; } }
    }
};
struct EpiResB {
    static constexpr bool PERM = true, AFTER_DRAIN = false, HAS_MID = false; static constexpr int RELAX = 8;
    bf16_t* xb; float alpha;
    __device__ __forceinline__ void operator()(const f32x4 (&acc)[2][2][4][2], const Unit2& u, int wr, int wc, int fr, int fq) const {
        const int row0 = u.pm * BM + wr * 64 + fr, col0 = u.pn * BM + wc * 32 + 8 * fq;
#pragma unroll
        for (int ai = 0; ai < 2; ++ai) {
            u32x4 xw[4][2];
#pragma unroll
            for (int m = 0; m < 4; ++m)
#pragma unroll
                for (int bj = 0; bj < 2; ++bj) xw[m][bj] = *(const u32x4*)(xb + (size_t)(row0 + ai * HALF + m * 16) * 1024 + col0 + bj * HALF);
#pragma unroll
            for (int m = 0; m < 4; ++m) { bf16_t* p = xb + (size_t)(row0 + ai * HALF + m * 16) * 1024 + col0;
#pragma unroll
                for (int bj = 0; bj < 2; ++bj) { f32x4 x0, x1; unpack8(xw[m][bj], x0, x1);
                    *(u32x4*)(p + bj * HALF) = pack8(x0 * alpha + acc[ai][bj][m][0], x1 * alpha + acc[ai][bj][m][1]); } } }
    }
};
struct EpiSwiglu {
    static constexpr bool PERM = true, AFTER_DRAIN = false, HAS_MID = false; static constexpr int RELAX = 0;
    bf16_t* HMp;
    __device__ __forceinline__ void operator()(const f32x4 (&acc)[2][2][4][2], const Unit2& u, int wr, int wc, int fr, int fq) const {
        const int rl0 = wr * 64 + fr, col0 = (u.pn & 3) * 128 + wc * 32 + 8 * fq;
        const __amdgpu_buffer_rsrc_t rs = __builtin_amdgcn_make_buffer_rsrc((void*)HMp, 0, 0x7ffffff0, 0x00020000);
#pragma unroll
        for (int ai = 0; ai < 2; ++ai)
#pragma unroll
            for (int m = 0; m < 4; ++m) { const int rl = rl0 + ai * HALF + m * 16;
                if (rl < u.nv) { f32x4 h0, h1;
#pragma unroll
                    for (int e = 0; e < 4; ++e) { const float g0 = acc[ai][0][m][0][e], g1 = acc[ai][0][m][1][e];
                        h0[e] = g0 * sigmoidf_fast(g0) * acc[ai][1][m][0][e]; h1[e] = g1 * sigmoidf_fast(g1) * acc[ai][1][m][1][e]; }
                    __builtin_amdgcn_raw_buffer_store_b128(pack8(h0, h1), rs, (unsigned)u.rtg * HM_TILEB + (unsigned)(col0 >> 5) * HM_STRIPB + (unsigned)(rl * 64 + (col0 & 31) * 2), 0, 16); } }
    }
};
struct EpiDown {
    static constexpr bool PERM = true, AFTER_DRAIN = false, HAS_MID = false; static constexpr int RELAX = 0;
    bf16_t* YSp; const int2* list;
    __device__ __forceinline__ void operator()(const f32x4 (&acc)[2][2][4][2], const Unit2& u, int wr, int wc, int fr, int fq) const {
        const int rl0 = wr * 64 + fr, col0 = (u.pn & 3) * BM + wc * 32 + 8 * fq;
        int aid[2][4]; float w[2][4];
#pragma unroll
        for (int ai = 0; ai < 2; ++ai)
#pragma unroll
            for (int m = 0; m < 4; ++m) { int rl = rl0 + ai * HALF + m * 16; rl = rl < u.nv ? rl : u.nv - 1; const int2 en = list[u.e * 32768 + u.r0 + rl]; aid[ai][m] = en.x; w[ai][m] = __int_as_float(en.y); }
#pragma unroll
        for (int ai = 0; ai < 2; ++ai)
#pragma unroll
            for (int m = 0; m < 4; ++m) { const int rl = rl0 + ai * HALF + m * 16;
                if (rl < u.nv) { bf16_t* p = YSp + (size_t)aid[ai][m] * 1024 + col0;
#pragma unroll
                    for (int bj = 0; bj < 2; ++bj) *(u32x4*)(p + bj * HALF) = pack8(acc[ai][bj][m][0] * w[ai][m], acc[ai][bj][m][1] * w[ai][m]); } }
    }
};
template <class Epi, class Sched, bool ALIGN_EPI = true>
__device__ __forceinline__ void gemm_phase2(PG8_LAS unsigned char* lds, const Gemm g, const Sched& S, const Epi& E, const int wid_in) {
    constexpr bool SP2 = true;
    int tid_ = wid_in * 64 + (int)__builtin_amdgcn_mbcnt_hi(~0u, __builtin_amdgcn_mbcnt_lo(~0u, 0u)); asm volatile("" : "+v"(tid_));
    const int tid = tid_, wid = __builtin_amdgcn_readfirstlane(tid >> 6), lane = tid & 63, wr = wid >> 2, wc = wid & 3, fr = lane & 15, fq = lane >> 4;
    const int K = g.K, nt = K / BK;
    unsigned voffB[2]; int RA[2], CA[2];
#pragma unroll
    for (int i = 0; i < 2; ++i) { int R, C; stage_rc(tid * 16 + i * 8192, R, C); const int Rb = Epi::PERM ? ((R & ~31) + perm32(R & 31)) : R;
        RA[i] = R; CA[i] = C; voffB[i] = (unsigned)(Rb * K + C) * 2u; }
    const size_t kstep = (size_t)(BK * 2);
    const size_t kstepA = Sched::A_KSTEP;
    const size_t hstep = (size_t)HALF * K * 2;
    const size_t tstep = 2 * hstep;
    const unsigned ldsw = (unsigned)wid * 1024u;
    const int aoff = lds_byte(wr * 64 + fr, fq * 8), boff = lds_byte(wc * 32 + fr, fq * 8);
#define PG8_SA(b, h) (((b) * 2 + (h)) * HTB)
#define PG8_SB(b, h) ((4 + (b) * 2 + (h)) * HTB)
#define PG8_STAGE(bufoff, gbase, voff) do { _Pragma("unroll") for (int _i = 0; _i < 2; ++_i) \
        __builtin_amdgcn_global_load_lds((const unsigned*)((const char*)(gbase) + (voff)[_i]), (PG8_LAS unsigned*)(lds + (bufoff) + ldsw + _i * 8192), 16, 0, 0); } while (0)
#define PG8_STAGEA(bufoff, gbase, voff) do { _Pragma("unroll") for (int _i = 0; _i < 2; ++_i) \
        __builtin_amdgcn_global_load_lds((const unsigned*)((const char*)(gbase) + (voff)[_i]), (PG8_LAS unsigned*)(lds + (bufoff) + ldsw + _i * 8192), 16, 0, Sched::A_AUX); } while (0)
#define PG8_LDA(dst, b, h) do { _Pragma("unroll") for (int m = 0; m < 4; ++m) _Pragma("unroll") for (int k = 0; k < 2; ++k) dst[m][k] = *(const PG8_LAS bf16x8*)(lds + PG8_SA(b, h) + aoff + m * 2048 + k * 1024); } while (0)
#define PG8_LDB(dst, b, h) do { _Pragma("unroll") for (int n = 0; n < 2; ++n) _Pragma("unroll") for (int k = 0; k < 2; ++k) dst[n][k] = *(const PG8_LAS bf16x8*)(lds + PG8_SB(b, h) + boff + n * 2048 + k * 1024); } while (0)
#define PG8_MMA(ai, bj, At, Bt) do { __builtin_amdgcn_s_setprio(1); _Pragma("unroll") for (int m = 0; m < 4; ++m) _Pragma("unroll") for (int n = 0; n < 2; ++n) _Pragma("unroll") for (int k = 0; k < 2; ++k) \
        acc[ai][bj][m][n] = __builtin_amdgcn_mfma_f32_16x16x32_bf16(Bt[n][k], At[m][k], acc[ai][bj][m][n], 0, 0, 0); __builtin_amdgcn_s_setprio(0); } while (0)
#define PG8_WAIT_V(n) asm volatile("s_waitcnt vmcnt(" #n ")" ::: "memory")
#define PG8_WAIT_VR(flag) do { static_assert(Epi::RELAX == 0 || Epi::RELAX == 8, "one relaxed count is written out"); \
        if constexpr (Epi::RELAX == 8) { const int f_ = __builtin_amdgcn_readfirstlane(flag); asm volatile("s_cmp_eq_u32 %0, 0\n\ts_cbranch_scc1 .Lwr%=\n\ts_waitcnt vmcnt(16)\n\ts_branch .Lwe%=\n.Lwr%=:\n\ts_waitcnt vmcnt(8)\n.Lwe%=:" :: "s"(f_) : "scc", "memory"); } \
        else asm volatile("s_waitcnt vmcnt(8)" ::: "memory"); } while (0)
#define PG8_WAIT_L(n) asm volatile("s_waitcnt lgkmcnt(" #n ")" ::: "memory")
#define PG8_BAR __builtin_amdgcn_s_barrier()
#define PG8_SCHED __builtin_amdgcn_sched_barrier(0)
    Unit2 cur, nxt; int ui = 0; int pend = -1;
    if (!S.next(0, cur)) return;
    f32x4 acc[2][2][4][2];
#pragma unroll
    for (int a = 0; a < 2; ++a)
#pragma unroll
        for (int b = 0; b < 2; ++b)
#pragma unroll
            for (int m = 0; m < 4; ++m)
#pragma unroll
                for (int n = 0; n < 2; ++n) acc[a][b][m][n] = (f32x4){0.f, 0.f, 0.f, 0.f};
    bf16x8 At[4][2], B0[2][2], B1[2][2];
    unsigned cvA[2][2];
    const char* cA; { int aid0[2][2]; S.a_issue(cur, RA, aid0); cA = S.a_finish(g, cur, RA, CA, aid0, cvA); } const char* cB = (const char*)g.Bt + (size_t)cur.pn * tstep;
    if constexpr (SP2) {
        PG8_STAGE(PG8_SB(0, 0), cB, voffB); PG8_STAGE(PG8_SB(0, 1), cB + hstep, voffB); PG8_STAGEA(PG8_SA(0, 0), cA, cvA[0]); PG8_STAGEA(PG8_SA(0, 1), cA, cvA[1]);
        if (wr == 1) PG8_BAR;
        PG8_WAIT_V(2); PG8_BAR;
        PG8_STAGE(PG8_SB(1, 0), cB + kstep, voffB); PG8_STAGEA(PG8_SA(1, 0), cA + kstepA, cvA[0]); PG8_STAGE(PG8_SB(1, 1), cB + hstep + kstep, voffB);
        PG8_WAIT_V(6); PG8_BAR;
    }
    for (;;) {
        const bool has_next = S.next(ui + 1, nxt);
        const char* nA = cA; const char* nB = has_next ? (const char*)g.Bt + (size_t)nxt.pn * tstep : cB;
        for (int t = 0; t < nt; t += 2) {
            const bool last = (t == nt - 2);
            const char* a1 = cA + (size_t)(t + 1) * kstepA;
            int aidn[2][2] = {{0, 0}, {0, 0}};
            if constexpr (Sched::PUBLISH) { if (t == 2 && pend >= 0) { S.publish(pend, lane); pend = -1; } }
            if constexpr (Epi::HAS_MID) { if (t == nt / 2) { PG8_SCHED; E.mid(acc, cur, wr, wc, fr, fq); PG8_SCHED; } }
            if (last && has_next) S.a_issue(nxt, RA, aidn);
            if constexpr (SP2) {
            PG8_LDB(B0, 0, 0); PG8_LDB(B1, 0, 1); PG8_SCHED; PG8_LDA(At, 0, 0); PG8_STAGEA(PG8_SA(1, 1), a1, cvA[1]);
            PG8_WAIT_VR((t == 0 && ui > 0) ? 1 : 0); PG8_WAIT_L(0); PG8_BAR; PG8_MMA(0, 0, At, B0); PG8_MMA(0, 1, At, B1); PG8_BAR; PG8_SCHED;
            if (last && has_next) nA = S.a_finish(g, nxt, RA, CA, aidn, cvA);
            const char* a2 = last ? nA : cA + (size_t)(t + 2) * kstepA; const char* b2 = last ? nB : cB + (size_t)(t + 2) * kstep;
            const char* a3 = a2 + kstepA; const char* b3 = b2 + kstep;
            PG8_LDA(At, 0, 1); PG8_STAGE(PG8_SB(0, 0), b2, voffB); PG8_STAGE(PG8_SB(0, 1), b2 + hstep, voffB); PG8_STAGEA(PG8_SA(0, 0), a2, cvA[0]);
            PG8_WAIT_VR((t == 0 && ui > 0) ? 1 : 0); PG8_WAIT_L(0); PG8_BAR; PG8_MMA(1, 0, At, B0); PG8_MMA(1, 1, At, B1); PG8_BAR; PG8_SCHED;
            PG8_LDB(B0, 1, 0); PG8_LDB(B1, 1, 1); PG8_SCHED; PG8_LDA(At, 1, 0); PG8_STAGEA(PG8_SA(0, 1), a2, cvA[1]);
            PG8_WAIT_V(8); PG8_WAIT_L(0); PG8_BAR; PG8_MMA(0, 0, At, B0); PG8_MMA(0, 1, At, B1); PG8_BAR; PG8_SCHED;
            PG8_LDA(At, 1, 1); PG8_STAGE(PG8_SB(1, 0), b3, voffB); PG8_STAGE(PG8_SB(1, 1), b3 + hstep, voffB); PG8_STAGEA(PG8_SA(1, 0), a3, cvA[0]);
            PG8_WAIT_V(8); PG8_WAIT_L(0); PG8_BAR; PG8_MMA(1, 0, At, B0); PG8_MMA(1, 1, At, B1); PG8_BAR; PG8_SCHED;
            }
        }
        if constexpr (ALIGN_EPI) { if (wr == 0) PG8_BAR; }
        E(acc, cur, wr, wc, fr, fq);
        if constexpr (Sched::PUBLISH) pend = cur.rtg;
        if (!has_next) break;
#pragma unroll
        for (int a = 0; a < 2; ++a)
#pragma unroll
            for (int b = 0; b < 2; ++b)
#pragma unroll
                for (int m = 0; m < 4; ++m)
#pragma unroll
                    for (int n = 0; n < 2; ++n) acc[a][b][m][n] = (f32x4){0.f, 0.f, 0.f, 0.f};
        cur = nxt; cA = nA; cB = nB; ++ui;
        if constexpr (ALIGN_EPI) { if (wr == 1) PG8_BAR; }
    }
    PG8_WAIT_V(0);
    if constexpr (Sched::PUBLISH) { if (pend >= 0) S.publish(pend, lane); }
    if constexpr (!ALIGN_EPI) { if (wr == 0) PG8_BAR; }
    PG8_BAR;
#undef PG8_SA
#undef PG8_SB
#undef PG8_STAGE
#undef PG8_STAGEA
#undef PG8_LDA
#undef PG8_LDB
#undef PG8_MMA
#undef PG8_WAIT_V
#undef PG8_WAIT_VR
#undef PG8_WAIT_L
#undef PG8_BAR
#undef PG8_SCHED
}

}
#include <hip/hip_bf16.h>

#define ATTN_STORE16(p,v) (*(u32x4*)(p)=(v))
namespace attn_b {
using bf16=__hip_bfloat16;
using bf16x8=__attribute__((ext_vector_type(8)))short;
using s16x4=__attribute__((ext_vector_type(4)))short;
using f32x16=__attribute__((ext_vector_type(16)))float;
using u32x4=__attribute__((ext_vector_type(4)))unsigned;
constexpr int BATCH=4,SEQ=8192,D=64,QP=512,KP=512,VP=512,OP=1024;
constexpr int NW=8,QBLK=32,QB=QBLK*NW,KVBLK=64,NQB=SEQ/QB;
constexpr int ATTN_UNIT_ROWS=QB;
__device__ __forceinline__ int crow(int r,int hi){return (r&3)+8*(r>>2)+4*hi;}
#define SBAR() __builtin_amdgcn_sched_barrier(0)
__device__ __forceinline__ void cmask(f32x16&p0,f32x16&p1,int jb,int qrel,int hi){
  const float NEG=-INFINITY; int kb=64*jb+4*hi;
  #pragma unroll
  for(int r=0;r<16;++r){int kv=kb+(r&3)+8*(r>>2); if(kv>qrel)p0[r]=NEG; if(kv+32>qrel)p1[r]=NEG;}
}

constexpr int NSLOT=3, SLOTB=8192;
constexpr int LDS_K=0, LDS_V=NSLOT*SLOTB, LDS_WS=3*NSLOT*SLOTB, LDS_OST=LDS_WS+NW*64*4, LDS_BYTES=LDS_OST+NW*4096;
constexpr float C2=0.125f*1.4426950408889634f;
__device__ __forceinline__ void glds16(const void*gbase,unsigned voff,unsigned lds_dst){unsigned keep;
  asm volatile("s_mov_b32 %0, m0\n\ts_mov_b32 m0, %3\n\ts_nop 0\n\tglobal_load_lds_dwordx4 %1, %2\n\ts_mov_b32 m0, %0":"=&s"(keep):"v"(voff),"s"(gbase),"s"(lds_dst):"memory");}
__device__ __forceinline__ float max3f(float a,float b,float c){float r;asm("v_max3_f32 %0, %1, %2, %3":"=v"(r):"v"(a),"v"(b),"v"(c));return r;}
__device__ __forceinline__ float max2f(float a,float b){float r;asm("v_max_f32_e32 %0, %1, %2":"=v"(r):"v"(a),"v"(b));return r;}
__device__ __forceinline__ float fadd_s(float a,float b){float r;asm("v_add_f32_e32 %0, %1, %2":"=v"(r):"v"(a),"v"(b));return r;}
__device__ __forceinline__ float fsub_s(float a,float b){float r;asm("v_sub_f32_e32 %0, %1, %2":"=v"(r):"v"(a),"v"(b));return r;}
typedef float f32x2_t __attribute__((ext_vector_type(2))); typedef __bf16 bf16x2_t __attribute__((ext_vector_type(2)));
__device__ __forceinline__ unsigned cvtpk_s(float lo,float hi){f32x2_t v={lo,hi};bf16x2_t b=__builtin_convertvector(v,bf16x2_t);return __builtin_bit_cast(unsigned,b);}
#define WAIT_BAR(N) asm volatile("s_waitcnt vmcnt(" #N ") lgkmcnt(0)\n\ts_barrier":::"memory")

__device__ __forceinline__ void qkt(f32x16&p0,f32x16&p1,const char*Kslot,const bf16x8*qr,int r32,int hi){ const f32x16 zz=f32x16{};
  const char*kb=Kslot+hi*1024+r32*16;
  #pragma unroll
  for(int d0=0;d0<4;++d0){
    const bf16x8 b0=*reinterpret_cast<const bf16x8*>(kb+d0*2048);
    const bf16x8 b1=*reinterpret_cast<const bf16x8*>(kb+d0*2048+512);
    if(d0==0){p0=__builtin_amdgcn_mfma_f32_32x32x16_bf16(b0,qr[0],zz,0,0,0);p1=__builtin_amdgcn_mfma_f32_32x32x16_bf16(b1,qr[0],zz,0,0,0);}
    else{p0=__builtin_amdgcn_mfma_f32_32x32x16_bf16(b0,qr[d0],p0,0,0,0);p1=__builtin_amdgcn_mfma_f32_32x32x16_bf16(b1,qr[d0],p1,0,0,0);}}
}
typedef __attribute__((address_space(3))) const char* lds_cptr;
typedef short v4i16_t __attribute__((ext_vector_type(4)));
__device__ __forceinline__ void kload8(bf16x8*kf,lds_cptr kp){
  kf[0]=*(const __attribute__((address_space(3))) bf16x8*)(kp);      kf[1]=*(const __attribute__((address_space(3))) bf16x8*)(kp+512);
  kf[2]=*(const __attribute__((address_space(3))) bf16x8*)(kp+2048); kf[3]=*(const __attribute__((address_space(3))) bf16x8*)(kp+2560);
  kf[4]=*(const __attribute__((address_space(3))) bf16x8*)(kp+4096); kf[5]=*(const __attribute__((address_space(3))) bf16x8*)(kp+4608);
  kf[6]=*(const __attribute__((address_space(3))) bf16x8*)(kp+6144); kf[7]=*(const __attribute__((address_space(3))) bf16x8*)(kp+6656);
}
__device__ __forceinline__ void kload2(bf16x8*kf,lds_cptr kp,int j){ kf[2*j]=*(const __attribute__((address_space(3))) bf16x8*)(kp+j*2048); kf[2*j+1]=*(const __attribute__((address_space(3))) bf16x8*)(kp+j*2048+512); }
__device__ __forceinline__ s16x4 vtr(lds_cptr p){ return __builtin_bit_cast(s16x4,__builtin_amdgcn_ds_read_tr16_b64_v4i16((__attribute__((address_space(3))) v4i16_t*)p)); }
__device__ __forceinline__ float rowmax(const f32x16&p0,const f32x16&p1){
  float a=max3f(p0[0],p0[1],p1[0]),b=max3f(p0[2],p0[3],p1[1]);a=max3f(a,p1[2],p1[3]);
  #pragma unroll
  for(int r=4;r<16;r+=4){a=max3f(a,p0[r],p0[r+1]);b=max3f(b,p0[r+2],p0[r+3]);a=max3f(a,p1[r],p1[r+1]);b=max3f(b,p1[r+2],p1[r+3]);}
  const float m=max2f(a,b);
  auto rr=__builtin_amdgcn_permlane32_swap(__float_as_uint(m),__float_as_uint(m),false,false);
  return max2f(__uint_as_float(rr[0]),__uint_as_float(rr[1]));
}
__device__ __forceinline__ void pv(f32x16*o,int vb,bf16x8 pa0,bf16x8 pa1,bf16x8 pa2,bf16x8 pa3){
  #pragma unroll
  for(int d0=0;d0<4;++d0){s16x4 lo[4],hi[4];
    #pragma unroll
    for(int ks=0;ks<4;++ks){
      asm volatile("ds_read_b64_tr_b16 %0,%1 offset:%c2":"=&v"(lo[ks]):"v"(vb),"i"(d0*4096+ks*1024):"memory");
      asm volatile("ds_read_b64_tr_b16 %0,%1 offset:%c2":"=&v"(hi[ks]):"v"(vb),"i"(d0*4096+ks*1024+512):"memory");}
    asm volatile("s_waitcnt lgkmcnt(0)":::"memory");SBAR();
    #define PK(k) (bf16x8){lo[k][0],lo[k][1],lo[k][2],lo[k][3],hi[k][0],hi[k][1],hi[k][2],hi[k][3]}
    o[d0]=__builtin_amdgcn_mfma_f32_32x32x16_bf16(pa0,PK(0),o[d0],0,0,0);
    o[d0]=__builtin_amdgcn_mfma_f32_32x32x16_bf16(pa1,PK(1),o[d0],0,0,0);
    o[d0]=__builtin_amdgcn_mfma_f32_32x32x16_bf16(pa2,PK(2),o[d0],0,0,0);
    o[d0]=__builtin_amdgcn_mfma_f32_32x32x16_bf16(pa3,PK(3),o[d0],0,0,0);
    #undef PK
  }
}

template<int THRL> __device__ __forceinline__ void attn_unit(int b,int qc,int kc,int vc,int oc,int qb,const bf16*Q,const bf16*__restrict__ K,const bf16*__restrict__ V,bf16*O,char*shm,const int wid){
  const int lane=(int)__builtin_amdgcn_mbcnt_hi(~0u,__builtin_amdgcn_mbcnt_lo(~0u,0u)),r32=lane&31,hi=lane>>5;
  const long rowbase=(long)b*SEQ; const int q0=qb*QB;
  const bf16*Qw=Q+(rowbase+q0+wid*QBLK)*QP+qc;
  const bf16*Kh=K+rowbase*KP+kc,*Vh=V+rowbase*VP+vc;
  const unsigned lds0=(unsigned)(uintptr_t)shm;
  float*wsf=(float*)(shm+LDS_WS)+wid*64;
  const bf16*ksrc=Kh+wid*8; const unsigned koff=(unsigned)(lane*KP*2);
  const bf16*vsrc=Vh+(long)(16*(wid&3))*VP+(wid>>2)*32; const unsigned voff=(unsigned)(((lane>>2)*VP+(lane&3)*8)*2);
  const unsigned kdst=lds0+LDS_K+wid*1024, vdst=lds0+LDS_V+wid*1024;
  #define DMA_K(t,slot) glds16(ksrc+(long)(t)*KVBLK*KP,koff,(unsigned)__builtin_amdgcn_readfirstlane(kdst+(slot)))
  #define DMA_V(t,slot) do{ glds16(vsrc+(long)(t)*KVBLK*VP,voff,(unsigned)__builtin_amdgcn_readfirstlane(vdst+2*(slot))); glds16(vsrc+(long)(t)*KVBLK*VP+64,voff,(unsigned)__builtin_amdgcn_readfirstlane(vdst+2*(slot)+8192)); }while(0)
  const int vb0=(int)(lds0+LDS_V)+((lane>>4)&1)*32+(lane&3)*8+(4*hi+((lane&15)>>2))*64;
  const char*Kbase=shm+LDS_K; bf16x8 kf[8];
  const lds_cptr shm3=(lds_cptr)shm; const lds_cptr kp0=shm3+LDS_K+hi*1024+r32*16; const lds_cptr vp0=shm3+LDS_V+((lane>>4)&1)*32+(lane&3)*8+(4*hi+((lane&15)>>2))*64;
  const int NT=(q0+QB)/KVBLK;
  DMA_K(0,0);DMA_V(0,0);DMA_K(1,SLOTB);
  bf16x8 qr[4];
  #pragma unroll
  for(int d0=0;d0<4;++d0)qr[d0]=*reinterpret_cast<const bf16x8*>(&Qw[(long)r32*QP+d0*16+hi*8]);
  float mhat=0.f,l_reg=0.f;f32x16 o[4];o[0]=f32x16{};o[1]=f32x16{};o[2]=f32x16{};o[3]=f32x16{};const f32x16 zz=f32x16{};
  const int qrel=wid*QBLK+r32;
  #define CMASK(P0,P1,t) do{int jb_=(t)-(NT-4); if(jb_>=0)cmask(P0,P1,jb_,qrel,hi);}while(0)
  bool resc=false;
  #define START(P0,P1) do{ const float rm=rowmax(P0,P1); resc=false; mhat=rm; \
    _Pragma("unroll") for(int r=0;r<16;++r)P0[r]=__builtin_amdgcn_exp2f(fsub_s(P0[r],mhat)); }while(0)
  #define RESC() do{ if(resc){ asm volatile("s_waitcnt lgkmcnt(0)":::"memory"); \
      _Pragma("unroll") for(int d_=0;d_<4;++d_) _Pragma("unroll") for(int r=0;r<16;++r)o[d_][r]*=wsf[crow(r,hi)]; } }while(0)
  f32x16 pA0,pA1,pB0,pB1;
  int sl_prev=0,sl_cur=0,sl_next=SLOTB;
  #define ROT() do{sl_prev=sl_cur;sl_cur=sl_next;sl_next=(sl_next==(NSLOT-1)*SLOTB)?0:sl_next+SLOTB;}while(0)
  DMA_K(2,2*SLOTB);
  WAIT_BAR(4);
  qkt(pA0,pA1,Kbase,qr,r32,hi);asm volatile("s_nop 15\n\ts_nop 7":"+v"(pA0),"+v"(pA1));CMASK(pA0,pA1,0);
  START(pA0,pA1);
  _Pragma("unroll") for(int r=0;r<16;++r)pA1[r]=__builtin_amdgcn_exp2f(fsub_s(pA1[r],mhat));
  WAIT_BAR(0);
  DMA_K(3,0);DMA_V(1,SLOTB);
  ROT();
  kload8(kf,kp0+sl_cur);
  WAIT_BAR(3);
  s16x4 vlo[6],vhi[6]; u32x4 pw0,pw1,pw2,pw3;
  #define PKW(P,B) cvtpk_s(P[B],P[B+1])
  #define PAF(k) __builtin_bit_cast(bf16x8,pw##k)
  #define VFR(i) (bf16x8){vlo[i][0],vlo[i][1],vlo[i][2],vlo[i][3],vhi[i][0],vhi[i][1],vhi[i][2],vhi[i][3]}
  #define PIN(x) asm volatile("":"+v"(x))
  #define MX3(a,b,c) __builtin_fmaxf(__builtin_fmaxf((a),(b)),(c))
  #define GAPA(MF,A0,A1,A2,A3,W0,W1,PW) do{ MF; sacc+=A0; sacc+=A1; sacc+=A2; sacc+=A3; PIN(sacc); W0; W1; PIN(PW); SBAR(); }while(0)
  #define EX(v) __builtin_amdgcn_exp2f((v)-mhat)
  #define GAPB(MF,X,B) do{ MF; X[B]=EX(X[B]); X[B+1]=EX(X[B+1]); PIN(X); SBAR(); }while(0)
  #define VRD(w,db,ks) do{ vlo[w]=vtr(vp_+((db)*4096+(ks)*1024)); vhi[w]=vtr(vp_+((db)*4096+(ks)*1024+512)); }while(0)
  #define VRD2(G,w,db,ks) do{ if(G){ VRD(w,db,ks); SBAR(); } }while(0)
  #define KRD(G,j) do{ if(G){ kload2(kf,kp0+sl_next,j); SBAR(); } }while(0)
  #define STEP(C0,C1,P0,P1,t,GK,GV,GL) do{ SBAR(); \
    const lds_cptr vp_=vp0+2*sl_prev; \
    VRD(0,0,0); SBAR(); float sacc=(P0[0]+P0[1]); \
    GAPA(C0=__builtin_amdgcn_mfma_f32_32x32x16_bf16(kf[0],qr[0],zz,0,0,0), P0[2],P0[3],P0[4],P0[5],     pw0[0]=PKW(P0,0), pw0[1]=PKW(P0,2), pw0); \
    VRD(1,1,0); SBAR(); GAPA(C1=__builtin_amdgcn_mfma_f32_32x32x16_bf16(kf[1],qr[0],zz,0,0,0), P0[6],P0[7],P0[8],P0[9],     pw0[2]=PKW(P0,4), pw0[3]=PKW(P0,6), pw0); \
    VRD(2,2,0); SBAR(); GAPA(C0=__builtin_amdgcn_mfma_f32_32x32x16_bf16(kf[2],qr[1],C0,0,0,0),   P0[10],P0[11],P0[12],P0[13], pw1[0]=PKW(P0,8), pw1[1]=PKW(P0,10), pw1); \
    VRD(3,3,0); SBAR(); GAPA(C1=__builtin_amdgcn_mfma_f32_32x32x16_bf16(kf[3],qr[1],C1,0,0,0),   P0[14],P0[15],P1[0],P1[1],   pw1[2]=PKW(P0,12),pw1[3]=PKW(P0,14), pw1); \
    VRD(4,0,1); SBAR(); GAPA(C0=__builtin_amdgcn_mfma_f32_32x32x16_bf16(kf[4],qr[2],C0,0,0,0),   P1[2],P1[3],P1[4],P1[5],     pw2[0]=PKW(P1,0), pw2[1]=PKW(P1,2), pw2); \
    VRD(5,1,1); SBAR(); GAPA(C1=__builtin_amdgcn_mfma_f32_32x32x16_bf16(kf[5],qr[2],C1,0,0,0),   P1[6],P1[7],P1[8],P1[9],     pw2[2]=PKW(P1,4), pw2[3]=PKW(P1,6), pw2); \
    GAPA(C0=__builtin_amdgcn_mfma_f32_32x32x16_bf16(kf[6],qr[3],C0,0,0,0),   P1[10],P1[11],P1[12],P1[13], pw3[0]=PKW(P1,8), pw3[1]=PKW(P1,10), pw3); \
    GAPA(C1=__builtin_amdgcn_mfma_f32_32x32x16_bf16(kf[7],qr[3],C1,0,0,0),   P1[14],P1[15],0.f,0.f,       pw3[2]=PKW(P1,12),pw3[3]=PKW(P1,14), pw3); \
    l_reg+=sacc; \
    if(GK){DMA_K((t)+3,sl_cur);} if(GV){DMA_V((t)+1,sl_next);} \
    CMASK(C0,C1,t); \
    { float a=MX3(C0[0],C0[1],C1[0]),b=MX3(C0[2],C0[3],C1[1]); a=MX3(a,C1[2],C1[3]); \
      _Pragma("unroll") for(int r=4;r<16;r+=4){a=MX3(a,C0[r],C0[r+1]);b=MX3(b,C0[r+2],C0[r+3]);a=MX3(a,C1[r],C1[r+1]);b=MX3(b,C1[r+2],C1[r+3]);} \
      float rm=__builtin_fmaxf(a,b); { auto rr=__builtin_amdgcn_permlane32_swap(__float_as_uint(rm),__float_as_uint(rm),false,false); rm=__builtin_fmaxf(__uint_as_float(rr[0]),__uint_as_float(rr[1])); } \
      resc=false; rm-=mhat; \
      if(__builtin_expect(__any(rm>(float)THRL),0)){ const float dl=__builtin_fmaxf(rm,0.f); mhat+=dl; \
        const float f=__builtin_amdgcn_exp2f(-dl); l_reg*=f; if(hi==0)wsf[r32]=f; resc=true; } } \
    SBAR(); \
    GAPB(o[0]=__builtin_amdgcn_mfma_f32_32x32x16_bf16(PAF(0),VFR(0),o[0],0,0,0), C0,0); VRD2(true,0,2,1); \
    GAPB(o[1]=__builtin_amdgcn_mfma_f32_32x32x16_bf16(PAF(0),VFR(1),o[1],0,0,0), C0,2); VRD2(true,1,3,1); \
    GAPB(o[2]=__builtin_amdgcn_mfma_f32_32x32x16_bf16(PAF(0),VFR(2),o[2],0,0,0), C0,4); VRD2(true,2,0,2); \
    GAPB(o[3]=__builtin_amdgcn_mfma_f32_32x32x16_bf16(PAF(0),VFR(3),o[3],0,0,0), C0,6); VRD2(true,3,1,2); \
    GAPB(o[0]=__builtin_amdgcn_mfma_f32_32x32x16_bf16(PAF(1),VFR(4),o[0],0,0,0), C0,8); VRD2(true,4,2,2); \
    GAPB(o[1]=__builtin_amdgcn_mfma_f32_32x32x16_bf16(PAF(1),VFR(5),o[1],0,0,0), C0,10); VRD2(true,5,3,2); \
    GAPB(o[2]=__builtin_amdgcn_mfma_f32_32x32x16_bf16(PAF(1),VFR(0),o[2],0,0,0), C0,12); VRD2(true,0,0,3); \
    GAPB(o[3]=__builtin_amdgcn_mfma_f32_32x32x16_bf16(PAF(1),VFR(1),o[3],0,0,0), C0,14); VRD2(true,1,1,3); \
    GAPB(o[0]=__builtin_amdgcn_mfma_f32_32x32x16_bf16(PAF(2),VFR(2),o[0],0,0,0), C1,0); VRD2(true,2,2,3); \
    GAPB(o[1]=__builtin_amdgcn_mfma_f32_32x32x16_bf16(PAF(2),VFR(3),o[1],0,0,0), C1,2); VRD2(true,3,3,3); \
    KRD(GL,0); GAPB(o[2]=__builtin_amdgcn_mfma_f32_32x32x16_bf16(PAF(2),VFR(4),o[2],0,0,0), C1,4); \
    KRD(GL,1); GAPB(o[3]=__builtin_amdgcn_mfma_f32_32x32x16_bf16(PAF(2),VFR(5),o[3],0,0,0), C1,6); \
    KRD(GL,2); GAPB(o[0]=__builtin_amdgcn_mfma_f32_32x32x16_bf16(PAF(3),VFR(0),o[0],0,0,0), C1,8); \
    KRD(GL,3); GAPB(o[1]=__builtin_amdgcn_mfma_f32_32x32x16_bf16(PAF(3),VFR(1),o[1],0,0,0), C1,10); \
    GAPB(o[2]=__builtin_amdgcn_mfma_f32_32x32x16_bf16(PAF(3),VFR(2),o[2],0,0,0), C1,12); \
    GAPB(o[3]=__builtin_amdgcn_mfma_f32_32x32x16_bf16(PAF(3),VFR(3),o[3],0,0,0), C1,14); \
    }while(0)
  if(wid>=4)__builtin_amdgcn_s_setprio(1);
  int t=1;
  #undef CMASK
  #define CMASK(P0,P1,t) do{}while(0)
  for(;t+5<NT;t+=2){
    STEP(pB0,pB1,pA0,pA1,t,true,true,true);     WAIT_BAR(3); RESC(); ROT();
    STEP(pA0,pA1,pB0,pB1,t+1,true,true,true);   WAIT_BAR(3); RESC(); ROT();
  }
  #undef CMASK
  #define CMASK(P0,P1,t) do{int jb_=(t)-(NT-4); if(jb_>=0)cmask(P0,P1,jb_,qrel,hi);}while(0)
  #define ENDW(tt) do{ if((tt)+3<NT){WAIT_BAR(3);} else if((tt)+2<NT){WAIT_BAR(2);} else {WAIT_BAR(0);} }while(0)
  for(;t+1<NT;t+=2){
    STEP(pB0,pB1,pA0,pA1,t,(t+3<NT),(t+1<NT),(t+1<NT));       ENDW(t);   RESC(); ROT();
    STEP(pA0,pA1,pB0,pB1,t+1,(t+4<NT),(t+2<NT),(t+2<NT));     ENDW(t+1); RESC(); ROT();
  }
  STEP(pB0,pB1,pA0,pA1,NT-1,false,false,false); RESC();
  { float sacc=pB0[0]+pB0[1]; _Pragma("unroll") for(int r=2;r<16;++r)sacc+=pB0[r]; _Pragma("unroll") for(int r=0;r<16;++r)sacc+=pB1[r]; l_reg+=sacc;
    pw0=(u32x4){PKW(pB0,0),PKW(pB0,2),PKW(pB0,4),PKW(pB0,6)};pw1=(u32x4){PKW(pB0,8),PKW(pB0,10),PKW(pB0,12),PKW(pB0,14)};pw2=(u32x4){PKW(pB1,0),PKW(pB1,2),PKW(pB1,4),PKW(pB1,6)};pw3=(u32x4){PKW(pB1,8),PKW(pB1,10),PKW(pB1,12),PKW(pB1,14)};
    SBAR(); pv(o,vb0+2*sl_cur,PAF(0),PAF(1),PAF(2),PAF(3)); }
  #undef PKW
  #undef PAF
  #undef VFR
  #undef PIN
  #undef MX3
  #undef GAPA
  #undef GAPB
  #undef EX
  #undef VRD
  #undef KRD
  #undef VRD2
  #undef STEP
  #undef ENDW
  {auto rr=__builtin_amdgcn_permlane32_swap(__float_as_uint(l_reg),__float_as_uint(l_reg),false,false);l_reg=__uint_as_float(rr[0])+__uint_as_float(rr[1]);}
  if(hi==0)wsf[32+r32]=l_reg;asm volatile("s_waitcnt lgkmcnt(0)":::"memory");
  float rli[16];
  #pragma unroll
  for(int r=0;r<16;++r)rli[r]=__builtin_amdgcn_rcpf(wsf[32+crow(r,hi)]);
  bf16*Ow=O+(rowbase+q0+wid*QBLK)*OP+oc;
  { bf16*stg=(bf16*)(shm+LDS_OST)+wid*2048;
    #pragma unroll
    for(int dh=0;dh<2;++dh){
      #pragma unroll
      for(int r=0;r<16;++r){const int orow=crow(r,hi);
        #pragma unroll
        for(int d0=0;d0<2;++d0)stg[orow*64+d0*32+r32]=__float2bfloat16(o[2*dh+d0][r]*rli[r]);}
      asm volatile("s_waitcnt lgkmcnt(0)":::"memory");
      #pragma unroll
      for(int i=0;i<4;++i){const int row=i*8+(lane>>3),ch=lane&7; const u32x4 v=*(const u32x4*)(stg+row*64+ch*8); ATTN_STORE16(Ow+(long)row*OP+dh*64+ch*8,v);}
      asm volatile("s_waitcnt lgkmcnt(0)":::"memory"); } }
  __builtin_amdgcn_s_setprio(0);
  asm volatile("s_waitcnt lgkmcnt(0)\n\ts_barrier":::"memory");
  #undef DMA_K
  #undef DMA_V
  #undef CMASK
  #undef START
  #undef RESC
  #undef ROT
}
constexpr int ATTN_LDS_BYTES=LDS_BYTES;
struct AttnTensors { const bf16* Q; const bf16* K; const bf16* V; bf16* O; };
struct AttnUnit { int b, hm, qb; };
struct SlotOrder {
  int vcu, G;
  __device__ __forceinline__ SlotOrder(int grid,int block):vcu((grid%8==0)?(block%8)*(grid/8)+block/8:block),G(grid){}
  __device__ __forceinline__ bool next(int i,AttnUnit&u)const{ const int sl=vcu+(i>>2)*G; if(sl>=256)return false; const int x=sl>>5,h=(sl&31)>>3,s=8*(x&1)+(sl&7),k=i&3;
    u.b=x>>1; u.hm=2*h+(k&1); u.qb=(k<2)?s:31-s; return true; }
};
template<class Sched,class Hook,class Comb,int THRL=8> __device__ __forceinline__ void attn_phase(char*lds,const AttnTensors&T,const Sched&S,const Hook&H,const Comb&C,const int wid){
  AttnUnit u; int i=0;
  for(;S.next(i,u);++i){ const int h=u.hm>>1,m=u.hm&1; attn_unit<THRL>(u.b,u.hm*64,u.hm*64,h*128,m*512+h*128,u.qb,T.Q,T.K,T.V,T.O,lds,wid);
    if(i<4){ H(i); asm volatile("s_waitcnt lgkmcnt(0)\n\ts_barrier":::"memory"); } }
  const int nu=i;
  for(;i<4;++i){ H(i); asm volatile("s_waitcnt lgkmcnt(0)\n\ts_barrier":::"memory"); }
  asm volatile("s_waitcnt vmcnt(0)":::"memory");
  for(int j=0;j<nu;j+=2){ AttnUnit v; S.next(j,v); C(v,wid); }
}
}
__device__ __forceinline__ int lane_opaque() { int l = (int)__builtin_amdgcn_mbcnt_hi(~0u, __builtin_amdgcn_mbcnt_lo(~0u, 0u)); asm volatile("" : "+v"(l)); return l; }
struct Args { const float* in[24]; float* out; unsigned char* ws; double invf[32]; };
typedef const __attribute__((address_space(4))) Args* KArgsP;
__device__ __forceinline__ KArgsP kargs() { unsigned long long p = (unsigned long long)__builtin_amdgcn_kernarg_segment_ptr(); asm volatile("" : "+s"(p)); return (KArgsP)p; }
struct ExpertCvt {
    int gw, NGW, wid; LAS unsigned char* L;
    __device__ __forceinline__ void operator()(int c) const {
        KArgsP KA = kargs(); const float* w_eg = KA->in[19]; const float* w_eu = KA->in[20]; const float* w_ed = KA->in[21];
        bf16* WguT = (bf16*)(KA->ws + WS_WGU); bf16* WdT = (bf16*)(KA->ws + WS_WD); LAS float* scr = (LAS float*)(L + RING_OFF + wid * 16384);
        constexpr int I_EG = NE * (D / 64) * (FF / 32), I_ED = NE * (FF / 64) * (D / 32), NIT = 2 * I_EG + I_ED;
        int lane_ = (int)__builtin_amdgcn_mbcnt_hi(~0u, __builtin_amdgcn_mbcnt_lo(~0u, 0u)); asm volatile("" : "+v"(lane_)); const int lane = lane_;
        const int kmax = (NIT + NGW - 1) / NGW, kc = (kmax + 3) / 4;
        for (int k = c * kc; k < (c + 1) * kc && k < kmax; ++k) { int r = gw + k * NGW; if (r >= NIT) break;
            if (r < 2 * I_EG) { const int up = r >= I_EG; if (up) r -= I_EG; const int per = (D / 64) * (FF / 32), e = r / per, q = r % per, nblk = FF / 32, kb = q / nblk, nb = q % nblk, n0 = 32 * nb;
                transpose_item<true>((up ? w_eu : w_eg) + (size_t)e * D * FF, D, FF, WguT, 64 * kb, n0, e * 1024 + (n0 >> 7) * 256 + up * 128 + (n0 & 127), scr, lane); }
            else { r -= 2 * I_EG; const int per = (FF / 64) * (D / 32), e = r / per, q = r % per, nblk = D / 32, kb = q / nblk, nb = q % nblk;
                transpose_item<true>(w_ed + (size_t)e * FF * D, FF, D, WdT, 64 * kb, 32 * nb, e * 1024 + 32 * nb, scr, lane); } }
    }
};

struct CombineOwn {
    __device__ __forceinline__ void operator()(const attn_b::AttnUnit& u, int wid) const {
        KArgsP KA = kargs(); int lane_ = (int)__builtin_amdgcn_mbcnt_hi(~0u, __builtin_amdgcn_mbcnt_lo(~0u, 0u)); asm volatile("" : "+v"(lane_)); const int lane = lane_;
        const float* q1 = KA->in[4]; const float* k1 = KA->in[5]; const float* q2 = KA->in[6]; const float* k2 = KA->in[7]; const float* sgp = KA->in[8];
        float lam; { const float p1 = q1[lane] * k1[lane], p2 = q2[lane] * k2[lane]; lam = expf(wave_sum(p1)) - expf(wave_sum(p2)) + LAMBDA_INIT; }
        float sg[8];
#pragma unroll
        for (int e = 0; e < 8; ++e) sg[e] = sgp[(lane & 15) * 8 + e] * (1.f - LAMBDA_INIT);
        const int h = u.hm >> 1; const size_t t0 = (size_t)u.b * SEQ + (size_t)u.qb * 256 + wid * 32 + (lane >> 4);
        const bf16* O = (const bf16*)KA->out + h * 128 + (lane & 15) * 8; bf16* OB = (bf16*)KA->out + (size_t)T * 1024 + 512 + h * 128 + (lane & 15) * 8;
        v4u a[8], bb[8];
#pragma unroll
        for (int r = 0; r < 8; ++r) { const size_t t = t0 + r * 4; a[r] = *(const v4u*)(O + t * 1024); bb[r] = *(const v4u*)(O + t * 1024 + 512); }
#pragma unroll
        for (int r = 0; r < 8; ++r) { const size_t t = t0 + r * 4; float v[8]; float ss = 0.f;
#pragma unroll
            for (int e = 0; e < 4; ++e) { v[2 * e] = bflo(a[r][e]) - lam * bflo(bb[r][e]); v[2 * e + 1] = bfhi(a[r][e]) - lam * bfhi(bb[r][e]); ss += v[2 * e] * v[2 * e] + v[2 * e + 1] * v[2 * e + 1]; }
            ss += __shfl_xor(ss, 1); ss += __shfl_xor(ss, 2); ss += __shfl_xor(ss, 4); ss += __shfl_xor(ss, 8);
            const float rs = 1.f / sqrtf(ss * (1.f / 128.f) + SUBLN_EPS); v4u o;
#pragma unroll
            for (int e = 0; e < 4; ++e) o[e] = pk2(v[2 * e] * rs * sg[2 * e], v[2 * e + 1] * rs * sg[2 * e + 1]);
            *(v4u*)(OB + t * 1024) = o; }
    }
};

__global__ void __launch_bounds__(NWAVES * 64, 2) fwd(Args) {
    extern __shared__ __attribute__((aligned(16))) unsigned char lds[];
    LAS unsigned char* L = (LAS unsigned char*)lds;
    KArgsP KA = kargs();
    volatile LAS unsigned* MISC = (volatile LAS unsigned*)(L + MISC_OFF);
    const int tid = threadIdx.x, wave0 = __builtin_amdgcn_readfirstlane(tid >> 6);
    const int G0 = gridDim.x;
    const int vcu0 = (G0 % 8 == 0) ? ((int)blockIdx.x % 8) * (G0 / 8) + (int)blockIdx.x / 8 : (int)blockIdx.x;
    for (int u = tid; u < (LDS_BYTES - LDSCTL_OFF) / 4; u += NWAVES * 64) ((LAS unsigned*)(L + LDSCTL_OFF))[u] = 0u;
    __syncthreads();
    XcdBarrier bar = xcd_barrier_post((unsigned*)((gu32*)(KA->ws + WS_CTL) + CW_BAR), MISC + 8);
#define GRID_BAR() xcd_barrier(bar)
#define COUNT_BAR(word) do { asm volatile("s_waitcnt vmcnt(0)" ::: "memory"); __syncthreads(); \
        if (threadIdx.x == 0) { unsigned* cw_ = (unsigned*)(kargs()->ws + WS_CTL) + (word); (void)__hip_atomic_fetch_add(cw_, 1u, RLX_AGENT); unsigned sp_ = 0; \
            while (__hip_atomic_load(cw_, RLX_AGENT) < gridDim.x && ++sp_ < (1u << 26)) __builtin_amdgcn_s_sleep(1); \
            __builtin_amdgcn_fence(__ATOMIC_ACQUIRE, "agent"); asm volatile("s_waitcnt vmcnt(0)" ::: "memory"); } \
        __syncthreads(); } while (0)
#define PAIR_BAR() do { if (__builtin_amdgcn_readfirstlane(bar.st[2]) == 0u) xcd_barrier_pair(bar); else xcd_barrier(bar); } while (0)
#define LOCAL_BAR() do { if (__builtin_amdgcn_readfirstlane(bar.st[2]) == 0u) xcd_barrier_local(bar); else xcd_barrier(bar); } while (0)

#define XIN ((const float*)KA->in[0])
#define positions ((const int*)KA->in[1])
#define w_in (KA->in[2])
#define b_gate (KA->in[3])
#define lq1 (KA->in[4])
#define lk1 (KA->in[5])
#define lq2 (KA->in[6])
#define lk2 (KA->in[7])
#define subln_g (KA->in[8])
#define w_o_att (KA->in[9])
#define conv_w (KA->in[10])
#define w_o_conv (KA->in[11])
#define w_mix (KA->in[12])
#define ln1_g (KA->in[13])
#define ln1_b (KA->in[14])
#define w_rg (KA->in[15])
#define b_rg (KA->in[16])
#define w_re (KA->in[17])
#define b_re (KA->in[18])
#define w_eg (KA->in[19])
#define w_eu (KA->in[20])
#define w_ed (KA->in[21])
#define ln2_g (KA->in[22])
#define ln2_b (KA->in[23])
#define out (KA->out)
#define ROPE ((float2*)(KA->ws + WS_ROPE))
#define LIST ((int2*)(KA->ws + WS_LIST))
#define WRT ((float*)(KA->ws + WS_WRT))
#define WinT ((bf16*)(KA->ws + WS_WIN))
#define WcatT ((bf16*)(KA->ws + WS_WOA))
#define WmixT ((bf16*)(KA->ws + WS_WMIX))
#define WguT ((bf16*)(KA->ws + WS_WGU))
#define WdT ((bf16*)(KA->ws + WS_WD))
#define XB ((bf16*)(KA->ws + WS_XB))
#define OR ((bf16*)out)
#define YS ((bf16*)(KA->ws + WS_YS))
#define QB ((bf16*)(KA->ws + WS_Q))
#define KB ((bf16*)(KA->ws + WS_K))
#define VB ((bf16*)(KA->ws + WS_V))
#define MG ((bf16*)(KA->ws + WS_MG))
#define H1B ((bf16*)(KA->ws + WS_H1B))
#define CB ((bf16*)(KA->ws + WS_CB))
#define UB ((bf16*)(KA->ws + WS_U))
#define OBF ((bf16*)out + (size_t)T * 1024)
#define HM ((bf16*)(KA->ws + WS_HM))
#define GB ((bf16*)(KA->ws + WS_G))
#define CNT ((gu32*)(KA->ws + WS_CTL) + CW_CNT)
#define RDY ((unsigned*)(KA->ws + WS_CTL) + CW_RDY)

    KA = kargs();
    { int wave = wave0, G = G0, vcu = vcu0, bidx = (int)blockIdx.x; asm volatile("" : "+s"(wave), "+s"(G), "+s"(vcu), "+s"(bidx));
      const int gw = vcu * NWAVES + wave, NGW = G * NWAVES, NGT = NGW * 64; (void)gw; (void)NGW; (void)NGT; (void)bidx;
    {
        const int lane = lane_opaque(), gt = gw * 64 + lane; (void)gt;
        LAS float* scr = (LAS float*)(L + RING_OFF + wave * 16384);
        constexpr int I_IN = (D / 64) * (NPROJ / 32), I_OA = (512 / 64) * (D / 32), I_MIX = (D / 64) * (D / 32);
        constexpr int I_EG = NE * (D / 64) * (FF / 32), I_ED = NE * (FF / 64) * (D / 32);
        constexpr int NITEMS = I_IN + 2 * I_OA + I_MIX;
        for (int it = gw; it < NITEMS; it += NGW) {
            int r = it;
            if (r < I_IN) { const int nblk = NPROJ / 32, kb = r / nblk, nb = r % nblk; transpose_item<true>(w_in, D, NPROJ, WinT, 64 * kb, 32 * nb, n_of(32 * nb), scr, lane); continue; } r -= I_IN;
            if (r < I_OA) { const int nblk = D / 32, kb = r / nblk, nb = r % nblk; transpose_item(w_o_att, 512, D, WcatT + 512, 64 * kb, 32 * nb, 32 * nb, scr, lane, 1024); continue; } r -= I_OA;
            if (r < I_OA) { const int nblk = D / 32, kb = r / nblk, nb = r % nblk; transpose_item(w_o_conv, 512, D, WcatT, 64 * kb, 32 * nb, 32 * nb, scr, lane, 1024); continue; } r -= I_OA;
            { const int nblk = D / 32, kb = r / nblk, nb = r % nblk; transpose_item(w_mix, D, D, WmixT, 64 * kb, 32 * nb, 32 * nb, scr, lane); }
        }
        asm volatile("s_waitcnt vmcnt(0)" ::: "memory"); __syncthreads();
        if (threadIdx.x == 0) (void)__hip_atomic_fetch_add((unsigned*)(KA->ws + WS_CTL) + CW_WDONE, 1u, RLX_AGENT);
        { const size_t XCH = (size_t)T * D / 4 / 8; const size_t nxt = (G % 8 == 0) ? (size_t)NGT / 8 : (size_t)NGT, xq = (G % 8 == 0) ? (size_t)gt / nxt : 0, xb0 = xq * XCH, xe = (G % 8 == 0) ? xb0 + XCH : (size_t)T * D / 4, tx = (G % 8 == 0) ? (size_t)gt % nxt : (size_t)gt;
        for (size_t i = xb0 + tx; i < xe; i += nxt * 16) { f32x4 v[16];
#pragma unroll
            for (int q = 0; q < 16; ++q) v[q] = (i + (size_t)q * nxt < xe) ? ((const f32x4*)XIN)[i + (size_t)q * nxt] : (f32x4){0.f, 0.f, 0.f, 0.f};
#pragma unroll
            for (int q = 0; q < 16; ++q) if (i + (size_t)q * nxt < xe) { v2u o; o.x = pk2(v[q].x, v[q].y); o.y = pk2(v[q].z, v[q].w); ((v2u*)XB)[i + (size_t)q * nxt] = o; } }
          const int RCH = T * 32 / 8, rb0 = (G % 8 == 0) ? (int)xq * RCH : 0, re = (G % 8 == 0) ? rb0 + RCH : T * 32;
          for (int i = rb0 + (int)tx; i < re; i += (int)nxt) { const int t = i >> 5, f = i & 31; const double ang = (double)positions[t] * KA->invf[f];
            const double k = rint(ang * 0.15915494309189535); double r = fma(-k, 6.283185307179586, ang); r = fma(-k, 2.4492935982947064e-16, r);
            const float rf = (float)r; ROPE[i] = make_float2(cosf(rf), sinf(rf)); } }
        for (int i = gt; i < 36 * D; i += NGT) { const int c = i >> 10, k = i & (D - 1); WRT[i] = c < 32 ? w_re[(size_t)k * 32 + c] : w_rg[(size_t)k * 4 + (c - 32)]; }
        if (threadIdx.x == 0) { unsigned sp = 0; while (__hip_atomic_load((unsigned*)(KA->ws + WS_CTL) + CW_WDONE, RLX_AGENT) < (unsigned)G && ++sp < (1u << 24)) __builtin_amdgcn_s_sleep(2); }
    }
    if (threadIdx.x == 0) { unsigned nloc, nx, bad; xcd_barrier_complete(bar.bar, bar.x, nloc, nx, bad); bar.st[0] = nloc; bar.st[1] = nx; bar.st[2] = bad; }
    __syncthreads();
    LOCAL_BAR();

    }
    KA = kargs();
    { int wave = wave0, G = G0, vcu = vcu0, bidx = (int)blockIdx.x; asm volatile("" : "+s"(wave), "+s"(G), "+s"(vcu), "+s"(bidx));
      const int gw = vcu * NWAVES + wave, NGW = G * NWAVES, NGT = NGW * 64; (void)gw; (void)NGW; (void)NGT; (void)bidx;
    {
        pg8::Gemm g{XB, WinT, T, NPROJ, D}; pg8::StaticOrder S; S.init(T, NPROJ, G, bidx);
        pg8::EpiProj E{QB, KB, VB, CB, UB, GB, (const float*)ROPE, b_gate, C2};
        pg8::gemm_phase<pg8::EpiProj, pg8::StaticOrder, true, true>(L + RING_OFF, g, S, E, wave);
    }
    PAIR_BAR();

    }
    KA = kargs();
    { int wave = wave0, G = G0, vcu = vcu0, bidx = (int)blockIdx.x; asm volatile("" : "+s"(wave), "+s"(G), "+s"(vcu), "+s"(bidx));
      const int gw = vcu * NWAVES + wave, NGW = G * NWAVES, NGT = NGW * 64; (void)gw; (void)NGW; (void)NGT; (void)bidx;
    { const int lane = lane_opaque(), gt = gw * 64 + lane;
    float cw[3][8];
    { const int c0 = (gt & 63) * 8;
#pragma unroll
      for (int k = 0; k < 3; ++k)
#pragma unroll
          for (int e = 0; e < 8; ++e) cw[k][e] = conv_w[k * 512 + c0 + e]; }
    const int XCH = T * 64 / 8, nxt = (G % 8 == 0) ? NGT / 8 : NGT, xbase = (G % 8 == 0) ? (gt / nxt) * XCH : 0, xend = (G % 8 == 0) ? xbase + XCH : T * 64, tx = (G % 8 == 0) ? gt % nxt : gt;
    for (int i0 = xbase + tx; i0 < xend; i0 += 4 * nxt) {
        v4u cbv[4], u2v[4], u1v[4], u0v[4];
#pragma unroll
        for (int q = 0; q < 4; ++q) { int i = i0 + q * nxt; i = i < xend ? i : xend - 1; const int ts = i >> 14, t = own_tile(ts) * 256 + ((i >> 6) & 255), c0 = (i & 63) * 8, s = t & (SEQ - 1);
            cbv[q] = *(const v4u*)(CB + (size_t)t * 512 + c0); u2v[q] = *(const v4u*)(UB + (size_t)t * 512 + c0);
            u1v[q] = *(const v4u*)(UB + (size_t)(t - (s >= 1 ? 1 : 0)) * 512 + c0);
            u0v[q] = *(const v4u*)(UB + (size_t)(t - (s >= 2 ? 2 : 0)) * 512 + c0); }
#pragma unroll
        for (int q = 0; q < 4; ++q) { const int i = i0 + q * nxt, ts = i >> 14, t = own_tile(ts) * 256 + ((i >> 6) & 255), c0 = (i & 63) * 8, s = t & (SEQ - 1); if (i >= xend) continue;
            const v4u cb = cbv[q], u2 = u2v[q]; v4u u1 = u1v[q], u0 = u0v[q]; v4u o;
            if (s < 1) u1 = (v4u){0u, 0u, 0u, 0u};
            if (s < 2) u0 = (v4u){0u, 0u, 0u, 0u};
#pragma unroll
            for (int j = 0; j < 4; ++j) {
                const float ylo = cw[0][2 * j] * bflo(u0[j]) + cw[1][2 * j] * bflo(u1[j]) + cw[2][2 * j] * bflo(u2[j]);
                const float yhi = cw[0][2 * j + 1] * bfhi(u0[j]) + cw[1][2 * j + 1] * bfhi(u1[j]) + cw[2][2 * j + 1] * bfhi(u2[j]);
                o[j] = pk2(bflo(cb[j]) * ylo, bfhi(cb[j]) * yhi); }
            *(v4u*)(OBF + (size_t)t * 1024 + c0) = o; } }
    __syncthreads(); if (threadIdx.x == 0) (void)__hip_atomic_fetch_add((unsigned*)(KA->ws + WS_CTL) + CW_P2DONE, 1u, RLX_AGENT); }

    }
    KA = kargs();
    { int wave = wave0, G = G0, vcu = vcu0, bidx = (int)blockIdx.x; asm volatile("" : "+s"(wave), "+s"(G), "+s"(vcu), "+s"(bidx));
      const int gw = vcu * NWAVES + wave, NGW = G * NWAVES, NGT = NGW * 64; (void)gw; (void)NGW; (void)NGT; (void)bidx;
    {
        const attn_b::AttnTensors AT{(const attn_b::bf16*)QB, (const attn_b::bf16*)KB, (const attn_b::bf16*)VB, (attn_b::bf16*)OR};
        const attn_b::SlotOrder S(G, bidx);
        const ExpertCvt H{gw, NGW, wave, L}; const CombineOwn C{};
        attn_b::attn_phase<attn_b::SlotOrder, ExpertCvt, CombineOwn>((char*)lds + RING_OFF, AT, S, H, C, wave);
    }
    LOCAL_BAR();

    }
    KA = kargs();
    { int wave = wave0, G = G0, vcu = vcu0, bidx = (int)blockIdx.x; asm volatile("" : "+s"(wave), "+s"(G), "+s"(vcu), "+s"(bidx));
      const int gw = vcu * NWAVES + wave, NGW = G * NWAVES, NGT = NGW * 64; (void)gw; (void)NGW; (void)NGT; (void)bidx;
    {
        if (threadIdx.x == 0) { unsigned sp = 0; while (__hip_atomic_load((unsigned*)(KA->ws + WS_CTL) + CW_P2DONE, RLX_AGENT) < (unsigned)G && ++sp < (1u << 24)) __builtin_amdgcn_s_sleep(2); }
        __syncthreads();
        pg8::PlainSrc S; S.init(T, 1024, G, bidx);
        { pg8::Gemm g{OBF, WcatT, T, 1024, D}; pg8::EpiMerge E{MG, GB}; pg8::gemm_phase2<pg8::EpiMerge, pg8::PlainSrc>(L + RING_OFF, g, S, E, wave); }
    }
    LOCAL_BAR();

    }
    KA = kargs();
    { int wave = wave0, G = G0, vcu = vcu0, bidx = (int)blockIdx.x; asm volatile("" : "+s"(wave), "+s"(G), "+s"(vcu), "+s"(bidx));
      const int gw = vcu * NWAVES + wave, NGW = G * NWAVES, NGT = NGW * 64; (void)gw; (void)NGW; (void)NGT; (void)bidx;
    {
        pg8::PlainSrc S; S.init(T, 1024, G, bidx); S.rev = 1;
        pg8::Gemm g{MG, WmixT, T, 1024, D}; pg8::EpiResB E{XB, ALPHA}; pg8::gemm_phase2<pg8::EpiResB, pg8::PlainSrc>(L + RING_OFF, g, S, E, wave);
    }
    LOCAL_BAR();

    }
    KA = kargs();
    { int wave = wave0, G = G0, vcu = vcu0, bidx = (int)blockIdx.x; asm volatile("" : "+s"(wave), "+s"(G), "+s"(vcu), "+s"(bidx));
      const int gw = vcu * NWAVES + wave, NGW = G * NWAVES, NGT = NGW * 64; (void)gw; (void)NGW; (void)NGT; (void)bidx;
    {
        const int lane = lane_opaque(), tid7 = wave * 64 + lane;
        LAS float* HR = (LAS float*)(L + RING_OFF);
        LAS float* LG = (LAS float*)(L + LDSCTL_OFF + 2048);
        LAS int* CL = (LAS int*)(L + LDSCTL_OFF + 2048 + 4736);
        LAS int* RES = CL + 64;
        for (int blk = vcu; blk < T / 128; blk += G) {
            const int row0 = own_tile(blk >> 1) * 256 + (blk & 1) * 128;
            if (tid7 < 32) CL[tid7] = 0;
            f32x4 wE[16], wG[16];
            { const float* wep = WRT + (size_t)(lane & 31) * D + wave * 128 + 4 * (lane >> 5); const float* wgp = WRT + (size_t)(32 + (lane & 3)) * D + wave * 128 + 4 * (lane >> 5);
#pragma unroll
              for (int j = 0; j < 16; ++j) { wE[j] = *(const f32x4*)(wep + 8 * j); wG[j] = *(const f32x4*)(wgp + 8 * j); } }
            for (int sb = 0; sb < 4; ++sb) {
                v4u pw[4][2];
#pragma unroll
                for (int rr = 0; rr < 4; ++rr)
#pragma unroll
                    for (int j = 0; j < 2; ++j) pw[rr][j] = *(const v4u*)(XB + (size_t)(row0 + sb * 32 + wave * 4 + rr) * D + 8 * lane + 512 * j);
#pragma unroll
                for (int rp = 0; rp < 4; rp += 2) {
                    f32x4 v[2][4]; float rstd[2];
#pragma unroll
                    for (int a = 0; a < 2; ++a) { float sm = 0.f;
#pragma unroll
                        for (int j = 0; j < 2; ++j) { const v4u w = pw[rp + a][j];
                            v[a][2 * j] = (f32x4){bflo(w.x), bfhi(w.x), bflo(w.y), bfhi(w.y)}; v[a][2 * j + 1] = (f32x4){bflo(w.z), bfhi(w.z), bflo(w.w), bfhi(w.w)}; }
#pragma unroll
                        for (int j = 0; j < 4; ++j) sm += (v[a][j].x + v[a][j].y) + (v[a][j].z + v[a][j].w);
                        const float mean = wave_sum(sm) * (1.f / D); float s2 = 0.f;
#pragma unroll
                        for (int j = 0; j < 4; ++j) { v[a][j] = v[a][j] - mean; s2 += (v[a][j].x * v[a][j].x + v[a][j].y * v[a][j].y) + (v[a][j].z * v[a][j].z + v[a][j].w * v[a][j].w); }
                        rstd[a] = 1.f / sqrtf(wave_sum(s2) * (1.f / D) + LN_EPS); }
#pragma unroll
                    for (int j = 0; j < 2; ++j) { const int c0 = 8 * lane + 512 * j;
#pragma unroll
                        for (int q = 0; q < 2; ++q) { const f32x4 gg = *(const f32x4*)(ln1_g + c0 + 4 * q), bb = *(const f32x4*)(ln1_b + c0 + 4 * q);
#pragma unroll
                            for (int a = 0; a < 2; ++a) { v[a][2 * j + q] = v[a][2 * j + q] * rstd[a] * gg + bb; *(LAS f32x4*)(HR + (wave * 4 + rp + a) * 1028 + c0 + 4 * q) = v[a][2 * j + q]; } }
#pragma unroll
                        for (int a = 0; a < 2; ++a) { const int t = row0 + sb * 32 + wave * 4 + rp + a;
                            v4u o; o.x = pk2(v[a][2 * j].x, v[a][2 * j].y); o.y = pk2(v[a][2 * j].z, v[a][2 * j].w); o.z = pk2(v[a][2 * j + 1].x, v[a][2 * j + 1].y); o.w = pk2(v[a][2 * j + 1].z, v[a][2 * j + 1].w);
                            store16_wt((void*)(H1B + (size_t)t * D + c0), o); } } }
                __syncthreads();
                { const int r32 = lane & 31, half = lane >> 5;
                  const LAS float* hp = HR + r32 * 1028 + wave * 128 + 4 * half;
                  f32x16 a0 = f32x16{}; f32x4 g4 = (f32x4){0.f, 0.f, 0.f, 0.f};
#pragma unroll
                  for (int j = 0; j < 16; ++j) { const f32x4 hv = *(const LAS f32x4*)(hp + 8 * j), we = wE[j], wg = wG[j];
#pragma unroll
                      for (int q = 0; q < 4; ++q) { a0 = __builtin_amdgcn_mfma_f32_32x32x2f32(hv[q], we[q], a0, 0, 0, 0); g4 = __builtin_amdgcn_mfma_f32_4x4x1f32(hv[q], wg[q], g4, 0, 0, 0); }
                      if ((j & 3) == 3) __builtin_amdgcn_sched_barrier(0); }
                  __syncthreads();
#pragma unroll
                  for (int r = 0; r < 16; ++r) HR[(wave * 32 + r) * 64 + lane] = a0[r];
#pragma unroll
                  for (int i = 0; i < 4; ++i) HR[(wave * 32 + 16 + i) * 64 + lane] = g4[i];
                  __syncthreads();
                  if (wave < 5) {
#pragma unroll
                  for (int q = 0; q < 4; ++q) { const int rg = wave * 4 + q; float sm = 0.f;
#pragma unroll
                      for (int w2 = 0; w2 < 8; ++w2) sm += HR[(w2 * 32 + rg) * 64 + lane];
                      if (rg < 16) LG[crow(rg, half) * 37 + r32] = sm;
                      else { sm += __shfl_xor(sm, 32); if (lane < 32) LG[(4 * ((lane >> 2) & 7) + (rg - 16)) * 37 + 32 + (lane & 3)] = sm; } } }
                  __syncthreads(); }
                if (tid7 < 32) {
                    float pg[4], pe[32];
#pragma unroll
                    for (int e = 0; e < 32; ++e) pe[e] = LG[tid7 * 37 + e] + b_re[e];
#pragma unroll
                    for (int e = 0; e < 4; ++e) pg[e] = LG[tid7 * 37 + 32 + e] + b_rg[e];
                    int gs = 0; float gm = pg[0];
#pragma unroll
                    for (int e = 1; e < 4; ++e) if (pg[e] > gm) { gm = pg[e]; gs = e; }
                    float den = 0.f;
#pragma unroll
                    for (int e = 0; e < 4; ++e) den += expf(pg[e] - gm);
                    const float gwt = 1.f / den;
                    float ev[8];
#pragma unroll
                    for (int i = 0; i < 8; ++i) ev[i] = gs == 0 ? pe[i] : gs == 1 ? pe[8 + i] : gs == 2 ? pe[16 + i] : pe[24 + i];
                    int i0 = 0; float v0 = ev[0];
#pragma unroll
                    for (int i = 1; i < 8; ++i) if (ev[i] > v0) { v0 = ev[i]; i0 = i; }
                    int i1 = -1; float v1 = -INFINITY;
#pragma unroll
                    for (int i = 0; i < 8; ++i) if (i != i0 && ev[i] > v1) { v1 = ev[i]; i1 = i; }
                    const float ex = expf(v1 - v0), p0 = gwt / (1.f + ex), p1 = gwt * ex / (1.f + ex);
                    const int e0 = gs * 8 + i0, e1 = gs * 8 + i1;
                    const int lr0 = atomicAdd((int*)&CL[e0], 1), lr1 = atomicAdd((int*)&CL[e1], 1);
                    LAS int* rs = RES + (sb * 32 + tid7) * 6; rs[0] = e0; rs[1] = e1; rs[2] = lr0; rs[3] = lr1; rs[4] = __float_as_int(p0); rs[5] = __float_as_int(p1);
                }
            }
            __syncthreads();
            if (tid7 < 32) { const int c = CL[tid7]; CL[32 + tid7] = c ? (int)__hip_atomic_fetch_add(CNT + tid7, (unsigned)c, RLX_AGENT) : 0; }
            __syncthreads();
            if (tid7 < 128) { const int t = row0 + tid7; const LAS int* rs = RES + tid7 * 6; const int e0 = rs[0], e1 = rs[1];
                __hip_atomic_store((unsigned long long*)(LIST + e0 * LISTCAP + CL[32 + e0] + rs[2]), (unsigned long long)(unsigned)(2 * t) | ((unsigned long long)(unsigned)rs[4] << 32), RLX_AGENT);
                __hip_atomic_store((unsigned long long*)(LIST + e1 * LISTCAP + CL[32 + e1] + rs[3]), (unsigned long long)(unsigned)(2 * t + 1) | ((unsigned long long)(unsigned)rs[5] << 32), RLX_AGENT); }
            __syncthreads();
        }
    }
    xcd_barrier<false>(bar);
    }
    KA = kargs();
    { int wave = wave0, G = G0, vcu = vcu0, bidx = (int)blockIdx.x; asm volatile("" : "+s"(wave), "+s"(G), "+s"(vcu), "+s"(bidx));
      const int gw = vcu * NWAVES + wave, NGW = G * NWAVES, NGT = NGW * 64; (void)gw; (void)NGW; (void)NGT; (void)bidx;
    {
        { pg8::MoeSrc<0> S; S.init((const unsigned*)CNT, (LAS int*)(L + LDSCTL_OFF + 1024), G, vcu, 4, LIST, RDY, wave);
          pg8::Gemm g{H1B, WguT, 0, 0, D}; pg8::EpiSwiglu E{HM}; pg8::gemm_phase2<pg8::EpiSwiglu, pg8::MoeSrc<0>>(L + RING_OFF, g, S, E, wave); }
        { pg8::MoeSrc<1> S; S.init((const unsigned*)CNT, (LAS int*)(L + LDSCTL_OFF + 1024), G, vcu, 4, LIST, RDY, wave);
          pg8::Gemm g{HM, WdT, 0, 0, FF}; pg8::EpiDown E{YS, LIST}; pg8::gemm_phase2<pg8::EpiDown, pg8::MoeSrc<1>>(L + RING_OFF, g, S, E, wave); }
    }
    GRID_BAR();

    }
    KA = kargs();
    { int wave = wave0, G = G0, vcu = vcu0, bidx = (int)blockIdx.x; asm volatile("" : "+s"(wave), "+s"(G), "+s"(vcu), "+s"(bidx));
      const int gw = vcu * NWAVES + wave, NGW = G * NWAVES, NGT = NGW * 64; (void)gw; (void)NGW; (void)NGT; (void)bidx;
    { const int lane = lane_opaque();
    f32x4 g2[4], b2[4];
#pragma unroll
    for (int j = 0; j < 4; ++j) { g2[j] = *(const f32x4*)(ln2_g + 4 * lane + 256 * j); b2[j] = *(const f32x4*)(ln2_b + 4 * lane + 256 * j); }
    for (int t0 = gw * 4; t0 < T; t0 += NGW * 4) {
        v2u hw[4][4], y0[4][4], y1[4][4];
#pragma unroll
        for (int r = 0; r < 4; ++r)
#pragma unroll
            for (int j = 0; j < 4; ++j) { const int c0 = 4 * lane + 256 * j; const size_t t = (size_t)(t0 + r);
                hw[r][j] = *(const v2u*)(H1B + t * D + c0); y0[r][j] = *(const v2u*)(YS + (2 * t) * D + c0); y1[r][j] = *(const v2u*)(YS + (2 * t + 1) * D + c0); }
#pragma unroll
        for (int r = 0; r < 4; ++r) { const size_t t = (size_t)(t0 + r);
            f32x4 v[4]; float s = 0.f;
#pragma unroll
            for (int j = 0; j < 4; ++j) { const unsigned h0 = hw[r][j].x, h1 = hw[r][j].y, a0 = y0[r][j].x, a1 = y0[r][j].y, b0 = y1[r][j].x, b1 = y1[r][j].y;
                f32x4& w = v[j];
                w.x = ALPHA * bflo(h0) + (bflo(a0) + bflo(b0)); w.y = ALPHA * bfhi(h0) + (bfhi(a0) + bfhi(b0));
                w.z = ALPHA * bflo(h1) + (bflo(a1) + bflo(b1)); w.w = ALPHA * bfhi(h1) + (bfhi(a1) + bfhi(b1));
                s += (w.x + w.y) + (w.z + w.w); }
            const float mean = wave_sum(s) * (1.f / D); float s2 = 0.f;
#pragma unroll
            for (int j = 0; j < 4; ++j) { v[j] = v[j] - mean; s2 += (v[j].x * v[j].x + v[j].y * v[j].y) + (v[j].z * v[j].z + v[j].w * v[j].w); }
            const float rstd = 1.f / sqrtf(wave_sum(s2) * (1.f / D) + LN_EPS);
#pragma unroll
            for (int j = 0; j < 4; ++j) { const int c0 = 4 * lane + 256 * j;
                *(f32x4*)(out + t * D + c0) = v[j] * rstd * g2[j] + b2[j]; } }
    } }
    }
}

#undef XIN
#undef positions
#undef w_in
#undef b_gate
#undef lq1
#undef lk1
#undef lq2
#undef lk2
#undef subln_g
#undef w_o_att
#undef conv_w
#undef w_o_conv
#undef w_mix
#undef ln1_g
#undef ln1_b
#undef w_rg
#undef b_rg
#undef w_re
#undef b_re
#undef w_eg
#undef w_eu
#undef w_ed
#undef ln2_g
#undef ln2_b
#undef out
#undef ROPE
#undef LIST
#undef WRT
#undef WinT
#undef WcatT
#undef WmixT
#undef WguT
#undef WdT
#undef XB
#undef OR
#undef YS
#undef QB
#undef KB
#undef VB
#undef MG
#undef H1B
#undef CB
#undef UB
#undef OBF
#undef HM
#undef GB
#undef CNT
#undef RDY
extern "C" void kernel_launch(void* const* d_in, const int* in_sizes, int n_in, void* d_out, int out_size, void* d_ws, size_t ws_size, hipStream_t stream) {
    static int grid = 0;
    if (grid == 0) {
        if (n_in != 24 || in_sizes[0] != T * D || out_size != T * D || ws_size < WS_END) { fprintf(stderr, "kernel_launch: unexpected shapes (n_in %d, in0 %d, out %d, ws %zu); nothing launched\n", n_in, n_in > 0 ? in_sizes[0] : -1, out_size, ws_size); grid = -1; return; }
        int dev = 0, cus = 0, per_cu = 0;
        if (hipGetDevice(&dev) != hipSuccess || hipDeviceGetAttribute(&cus, hipDeviceAttributeMultiprocessorCount, dev) != hipSuccess) { grid = -1; return; }
        if (hipFuncSetAttribute((const void*)fwd, hipFuncAttributeMaxDynamicSharedMemorySize, LDS_BYTES) != hipSuccess) { fprintf(stderr, "kernel_launch: hipFuncSetAttribute failed\n"); grid = -1; return; }
        if (hipOccupancyMaxActiveBlocksPerMultiprocessor(&per_cu, (const void*)fwd, NWAVES * 64, LDS_BYTES) != hipSuccess || per_cu < 1) { fprintf(stderr, "kernel_launch: occupancy query says %d\n", per_cu); }
        (void)hipGetLastError();
        grid = cus;
    }
    if (grid < 0) return;
    if (hipMemsetAsync((char*)d_ws + WS_CTL, 0, CTL_ZERO_BYTES, stream) != hipSuccess) return;
    Args a{};
    for (int i = 0; i < 24; ++i) a.in[i] = (const float*)d_in[i];
    a.out = (float*)d_out; a.ws = (unsigned char*)d_ws;
    for (int i = 0; i < 32; ++i) a.invf[i] = pow(10000.0, -(double)i / 32.0);
    hipLaunchKernelGGL(fwd, dim3(grid), dim3(NWAVES * 64), LDS_BYTES, stream, a);
}
```
